# Optimizing an MI355X kernel written in HIP

```python
import jax, jax.numpy as jnp
from jax import lax
import numpy as np

D_MODEL = 1024
BATCH = 16
SEQ = 2048
DEPTH = 1

GRID_W = 64
HEAD_DIM = 64
NA_HEADS = 8
NA_WIN_H = 8
NA_WIN_W = 16
GQA_HEADS = 8
GQA_KV_HEADS = 2
Q_BLOCK = 128
ROPE_THETA = 10000.0
N_EXPERTS = 16
EC_CAPACITY_FACTOR = 2
D_EXPERT = 2816
NORM_EPS = 1e-6

NA_WIDTH = NA_HEADS * HEAD_DIM
GQA_WIDTH = GQA_HEADS * HEAD_DIM
GQA_KV_WIDTH = GQA_KV_HEADS * HEAD_DIM
MIX_WIDTH = NA_WIDTH + GQA_WIDTH
IN_WIDTH = 3 * NA_WIDTH + GQA_WIDTH + 2 * GQA_KV_WIDTH

kernel_name = "hymba_natten_gqa_axialrope_expert_choice"


def rms_norm(x, g):
    xf = x.astype(jnp.float32)
    y = xf * lax.rsqrt(jnp.mean(xf * xf, axis=-1, keepdims=True) + NORM_EPS)
    return (y * g.astype(jnp.float32)).astype(x.dtype)


def neighbourhood_attention(q, k, v, rpb):
    B, S, H, D = q.shape
    rows = S // GRID_W
    kh = min(NA_WIN_H, rows)
    kw = NA_WIN_W
    n_nb = kh * kw
    qg = q.reshape(B, rows, GRID_W, H, D)
    kg = k.reshape(B, rows, GRID_W, H, D)
    vg = v.reshape(B, rows, GRID_W, H, D)
    row_start = jnp.clip(jnp.arange(rows) - kh // 2, 0, rows - kh)
    col = jnp.arange(GRID_W)
    col_start = jnp.clip(col - kw // 2, 0, GRID_W - kw)
    col_idx = col_start[:, None] + jnp.arange(kw)[None, :]
    col_off = col_idx - col[:, None] + (NA_WIN_W - 1)
    scale = D ** -0.5

    def one_row(r):
        rs = row_start[r]
        k_rows = lax.dynamic_slice_in_dim(kg, rs, kh, axis=1)
        v_rows = lax.dynamic_slice_in_dim(vg, rs, kh, axis=1)
        k_nb = k_rows[:, :, col_idx].transpose(0, 2, 1, 3, 4, 5).reshape(B, GRID_W, n_nb, H, D)
        v_nb = v_rows[:, :, col_idx].transpose(0, 2, 1, 3, 4, 5).reshape(B, GRID_W, n_nb, H, D)
        q_r = lax.dynamic_index_in_dim(qg, r, axis=1, keepdims=False)
        s = jnp.einsum('bwhd,bwnhd->bhwn', q_r, k_nb).astype(jnp.float32) * scale
        row_off = rs + jnp.arange(kh) - r + (NA_WIN_H - 1)
        bias = rpb[:, row_off[:, None, None], col_off[None, :, :]]
        bias = bias.transpose(0, 2, 1, 3).reshape(H, GRID_W, n_nb)
        p = jax.nn.softmax(s + bias[None].astype(jnp.float32), axis=-1).astype(v.dtype)
        return jnp.einsum('bhwn,bwnhd->bwhd', p, v_nb)

    o = lax.map(one_row, jnp.arange(rows))
    return o.transpose(1, 0, 2, 3, 4).reshape(B, S, H * D)


def axial_rope_tables(S):
    t = jnp.arange(S)
    row = (t // GRID_W).astype(jnp.float32)
    col = (t % GRID_W).astype(jnp.float32)
    half = HEAD_DIM // 2
    inv_freq = 1.0 / (ROPE_THETA ** (jnp.arange(0, half, 2, dtype=jnp.float32) / half))
    ang = jnp.concatenate([row[:, None] * inv_freq[None], col[:, None] * inv_freq[None]], axis=-1)
    return jnp.cos(ang), jnp.sin(ang)


def apply_rope(x, cos, sin):
    B, S, H, D = x.shape
    xf = x.astype(jnp.float32).reshape(B, S, H, D // 2, 2)
    x0, x1 = xf[..., 0], xf[..., 1]
    c = cos[None, :, None, :]
    s = sin[None, :, None, :]
    out = jnp.stack([x0 * c - x1 * s, x0 * s + x1 * c], axis=-1)
    return out.reshape(B, S, H, D).astype(x.dtype)


def gqa_attention(q, k, v):
    B, S, Hq, D = q.shape
    Hkv = k.shape[2]
    G = Hq // Hkv
    scale = D ** -0.5
    qb = q.reshape(B, S // Q_BLOCK, Q_BLOCK, Hkv, G, D).transpose(1, 0, 2, 3, 4, 5)

    def block(qi):
        s = jnp.einsum('bqkgd,bskd->bkgqs', qi, k).astype(jnp.float32) * scale
        p = jax.nn.softmax(s, axis=-1).astype(v.dtype)
        return jnp.einsum('bkgqs,bskd->bqkgd', p, v)

    o = lax.map(block, qb)
    return o.transpose(1, 0, 2, 3, 4, 5).reshape(B, S, Hq * D)


def expert_choice_ffn(h, w_router, w_gate, w_up, w_down):
    B, S, D = h.shape
    cap = EC_CAPACITY_FACTOR * S // N_EXPERTS
    logits = jnp.einsum('bsd,de->bse', h, w_router).astype(jnp.float32)
    affinity = jax.nn.softmax(logits, axis=-1)
    gate, idx = lax.top_k(affinity.transpose(0, 2, 1), cap)
    xin = jax.vmap(lambda hb, ib: hb[ib])(h, idx)
    g = jnp.einsum('becd,edf->becf', xin, w_gate)
    u = jnp.einsum('becd,edf->becf', xin, w_up)
    y = jnp.einsum('becf,efd->becd', jax.nn.silu(g) * u, w_down)
    y = y * gate[..., None].astype(y.dtype)
    return jax.vmap(
        lambda ib, yb: jnp.zeros((S, D), yb.dtype).at[ib.reshape(-1)].add(yb.reshape(-1, D))
    )(idx, y)


def setup_inputs(seed: int = 0) -> dict:
    key = jax.random.key(seed)
    ks = jax.random.split(key, 16)
    f32 = jnp.float32

    def nrm(k, shape, fan_in):
        return jax.random.normal(k, shape, f32) * (fan_in ** -0.5)

    def gain(k, shape):
        return 1.0 + 0.02 * jax.random.normal(k, shape, f32)

    return {
        "x": jax.random.normal(ks[0], (BATCH, SEQ, D_MODEL), f32),
        "norm1_g": gain(ks[1], (DEPTH, D_MODEL)),
        "w_in": nrm(ks[2], (DEPTH, D_MODEL, IN_WIDTH), D_MODEL),
        "na_q_norm_g": gain(ks[3], (DEPTH, HEAD_DIM)),
        "na_k_norm_g": gain(ks[4], (DEPTH, HEAD_DIM)),
        "na_rpb": 0.02 * jax.random.normal(ks[5], (DEPTH, NA_HEADS, 2 * NA_WIN_H - 1, 2 * NA_WIN_W - 1), f32),
        "gqa_q_norm_g": gain(ks[6], (DEPTH, HEAD_DIM)),
        "gqa_k_norm_g": gain(ks[7], (DEPTH, HEAD_DIM)),
        "na_out_g": gain(ks[8], (DEPTH, NA_WIDTH)),
        "gqa_out_g": gain(ks[9], (DEPTH, GQA_WIDTH)),
        "w_out": nrm(ks[10], (DEPTH, MIX_WIDTH, D_MODEL), MIX_WIDTH),
        "norm2_g": gain(ks[11], (DEPTH, D_MODEL)),
        "w_router": nrm(ks[12], (DEPTH, D_MODEL, N_EXPERTS), D_MODEL),
        "w_gate": nrm(ks[13], (DEPTH, N_EXPERTS, D_MODEL, D_EXPERT), D_MODEL),
        "w_up": nrm(ks[14], (DEPTH, N_EXPERTS, D_MODEL, D_EXPERT), D_MODEL),
        "w_down": nrm(ks[15], (DEPTH, N_EXPERTS, D_EXPERT, D_MODEL), D_EXPERT),
    }


def reference(x, norm1_g, w_in, na_q_norm_g, na_k_norm_g, na_rpb, gqa_q_norm_g, gqa_k_norm_g,
              na_out_g, gqa_out_g, w_out, norm2_g, w_router, w_gate, w_up, w_down):
    B, S, _ = x.shape
    cos, sin = axial_rope_tables(S)
    splits = np.cumsum([NA_WIDTH, NA_WIDTH, NA_WIDTH, GQA_WIDTH, GQA_KV_WIDTH]).tolist()
    for l in range(DEPTH):
        u = rms_norm(x, norm1_g[l])
        proj = jnp.einsum('bsd,dn->bsn', u, w_in[l])
        qa, ka, va, qb, kb, vb = jnp.split(proj, splits, axis=-1)
        qa = rms_norm(qa.reshape(B, S, NA_HEADS, HEAD_DIM), na_q_norm_g[l])
        ka = rms_norm(ka.reshape(B, S, NA_HEADS, HEAD_DIM), na_k_norm_g[l])
        va = va.reshape(B, S, NA_HEADS, HEAD_DIM)
        out_a = neighbourhood_attention(qa, ka, va, na_rpb[l])
        qb = rms_norm(qb.reshape(B, S, GQA_HEADS, HEAD_DIM), gqa_q_norm_g[l])
        kb = rms_norm(kb.reshape(B, S, GQA_KV_HEADS, HEAD_DIM), gqa_k_norm_g[l])
        vb = vb.reshape(B, S, GQA_KV_HEADS, HEAD_DIM)
        qb = apply_rope(qb, cos, sin)
        kb = apply_rope(kb, cos, sin)
        out_b = gqa_attention(qb, kb, vb)
        mixed = jnp.concatenate([rms_norm(out_a, na_out_g[l]), rms_norm(out_b, gqa_out_g[l])], axis=-1)
        x = x + jnp.einsum('bsm,md->bsd', mixed, w_out[l])
        hn = rms_norm(x, norm2_g[l])
        x = x + expert_choice_ffn(hn, w_router[l], w_gate[l], w_up[l], w_down[l])
    return x
```

```cpp
#include <hip/hip_runtime.h>
#include <cstdio>
#include <cstdint>

#define DEVI __device__ __forceinline__
typedef _Float16 f16;
typedef _Float16 f16x2 __attribute__((ext_vector_type(2)));
typedef _Float16 f16x4 __attribute__((ext_vector_type(4)));
typedef _Float16 f16x8 __attribute__((ext_vector_type(8)));
typedef float f32x2 __attribute__((ext_vector_type(2)));
typedef float f32x4 __attribute__((ext_vector_type(4)));
typedef unsigned u32x4 __attribute__((ext_vector_type(4)));
typedef unsigned u32x2 __attribute__((ext_vector_type(2)));
typedef int i32x4 __attribute__((ext_vector_type(4)));
typedef int i32x8 __attribute__((ext_vector_type(8)));

constexpr int NB = 16, SEQ = 2048, DM = 1024, MTOK = NB * SEQ;
constexpr int GRIDW = 64, GROWS = SEQ / GRIDW;
constexpr int HD = 64, NAH = 8, GQH = 8, GKV = 2;
constexpr int INW = 2304, MIXW = 1024;
constexpr int NEXP = 16, CAP = 256, DEXP = 2816;
constexpr int C_NAQ = 0, C_NAK = 512, C_NAV = 1024, C_GQ = 1536, C_GK = 2048, C_GV = 2176;
constexpr float EPS = 1e-6f;
constexpr float LOG2E = 1.4426950408889634f;
constexpr float C2 = 0.125f * LOG2E;

constexpr size_t MiB = 1u << 20;
constexpr size_t WS_CTL = 0;
constexpr size_t WS_SSQP = 2 * MiB;
constexpr size_t WS_AFF = 4 * MiB;
constexpr size_t WS_RSTD2 = 6 * MiB;
constexpr size_t WS_IDX = 7 * MiB;
constexpr size_t WS_RSS = 7 * MiB + 256 * 1024;
constexpr size_t WS_GATE = 7 * MiB + 512 * 1024;
constexpr size_t WS_INV = 8 * MiB;
constexpr size_t WS_WINT = 16 * MiB;
constexpr size_t WS_WOT = 22 * MiB;
constexpr size_t WS_W1T = 24 * MiB;
constexpr size_t WS_W2T = 112 * MiB;
constexpr size_t WS_H8 = 156 * MiB;
constexpr size_t WS_XN = 188 * MiB;
constexpr size_t WS_H16 = 188 * MiB;
constexpr size_t WS_PROJ = 252 * MiB;
constexpr size_t WS_ATT = 396 * MiB;
constexpr size_t WS_ACT = 252 * MiB;
constexpr size_t WS_Y = 460 * MiB;
constexpr size_t WS_PART = 600 * MiB;
constexpr size_t WS_SSQ2P = 640 * MiB;
constexpr size_t WS_RMS1 = 11 * MiB;
constexpr size_t WS_WRT = 10 * MiB;
constexpr size_t WS_PCNT = 16384;
constexpr size_t CTL_ZERO_BYTES = 65536;
constexpr float W_SCALE = 32.f, H_SCALE = 16.f, A_SCALE = 8.f;
constexpr size_t WS_END = 704 * MiB;

struct RopeTab { float c[64][16]; float s[64][16]; };
constexpr double cx_exp(double x) {
    bool neg = x < 0; double y = neg ? -x : x; double term = 1.0, sum = 1.0;
    for (int i = 1; i < 80; ++i) { term *= y / i; sum += term; }
    return neg ? 1.0 / sum : sum;
}
constexpr double cx_sin(double r) { double term = r, sum = r; for (int i = 1; i < 20; ++i) { term *= -r * r / ((2 * i) * (2 * i + 1)); sum += term; } return sum; }
constexpr double cx_cos(double r) { double term = 1.0, sum = 1.0; for (int i = 1; i < 20; ++i) { term *= -r * r / ((2 * i - 1) * (2 * i)); sum += term; } return sum; }
constexpr RopeTab make_rope() {
    RopeTab t{};
    const double LN1E4 = 9.210340371976184, TWO_PI = 6.283185307179586476925;
    for (int j = 0; j < 16; ++j) {
        const double w = cx_exp(-(double)j / 16.0 * LN1E4);
        for (int p = 0; p < 64; ++p) {
            double a = (double)p * w; long k = (long)(a / TWO_PI + 0.5); double r = a - (double)k * TWO_PI;
            t.c[p][j] = (float)cx_cos(r); t.s[p][j] = (float)cx_sin(r);
        }
    }
    return t;
}
__device__ const RopeTab g_rope = make_rope();

#define DPP_ADD(v, ctrl) v += __builtin_bit_cast(float, __builtin_amdgcn_update_dpp(0, __builtin_bit_cast(int, v), ctrl, 0xF, 0xF, true))
DEVI float wave_sum(float v) {
    DPP_ADD(v, 0xB1);
    DPP_ADD(v, 0x4E);
    DPP_ADD(v, 0x141);
    DPP_ADD(v, 0x140);
    { auto r = __builtin_amdgcn_permlane16_swap(__float_as_uint(v), __float_as_uint(v), false, false); v = __uint_as_float(r[0]) + __uint_as_float(r[1]); }
    { auto r = __builtin_amdgcn_permlane32_swap(__float_as_uint(v), __float_as_uint(v), false, false); v = __uint_as_float(r[0]) + __uint_as_float(r[1]); }
    return v;
}
DEVI void h8_to_f(const u32x4 raw, float* f) {
    const f16x8 h = __builtin_bit_cast(f16x8, raw);
#pragma unroll
    for (int i = 0; i < 8; ++i) f[i] = (float)h[i];
}
DEVI float clamp448(float v) { return __builtin_fminf(__builtin_fmaxf(v, -448.f), 448.f); }
DEVI unsigned pk_f8x4(float a, float b, float c, float d) {
    int w = 0; w = __builtin_amdgcn_cvt_pk_fp8_f32(clamp448(a), clamp448(b), w, false); w = __builtin_amdgcn_cvt_pk_fp8_f32(clamp448(c), clamp448(d), w, true); return (unsigned)w; }
DEVI unsigned pk_h2(float a, float b) { f32x2 v = {a, b}; return __builtin_bit_cast(unsigned, __builtin_convertvector(v, f16x2)); }

__global__ __launch_bounds__(256) void k_rmsnorm1(const float* __restrict__ x, const float* __restrict__ g, f16* __restrict__ xn) {
    const int lane = threadIdx.x & 63, wave = threadIdx.x >> 6;
    const int row = blockIdx.x * 4 + wave;
    const f32x4* xr = (const f32x4*)(x + (size_t)row * DM) + lane;
    const f32x4* gr = (const f32x4*)g + lane;
    f32x4 v[4]; float s = 0.f;
#pragma unroll
    for (int j = 0; j < 4; ++j) { v[j] = xr[64 * j]; s += (v[j].x * v[j].x + v[j].y * v[j].y) + (v[j].z * v[j].z + v[j].w * v[j].w); }
    const float rstd = rsqrtf(wave_sum(s) * (1.f / DM) + EPS);
    u32x2* o = (u32x2*)(xn + (size_t)row * DM) + lane;
#pragma unroll
    for (int j = 0; j < 4; ++j) { const f32x4 gg = gr[64 * j]; u32x2 w; w.x = pk_h2(v[j].x * rstd * gg.x, v[j].y * rstd * gg.y); w.y = pk_h2(v[j].z * rstd * gg.z, v[j].w * rstd * gg.w); o[64 * j] = w; }
}

template <int NWM, class RowPtr, class WPtr, class Epi>
__global__ __launch_bounds__(256) void k_ngemm(long Kl, const float* __restrict__ kscale, RowPtr rp, WPtr wp, Epi epi) {
    const int K = (int)Kl;
    __shared__ float As[16][68];
    __shared__ float Ws[NWM][16][64];
    __shared__ float T[NWM][64][65];
    const int tid = threadIdx.x, ty = tid >> 4, tx = tid & 15, rt = blockIdx.y, ct = blockIdx.x;
    float acc[NWM][4][4];
#pragma unroll
    for (int w = 0; w < NWM; ++w)
#pragma unroll
        for (int i = 0; i < 4; ++i)
#pragma unroll
            for (int j = 0; j < 4; ++j) acc[w][i][j] = 0.f;
    const f16* arow = rp(rt, tid >> 2);
    const int ak = (tid & 3) * 4;
    int ldw = 0;
    const float* wb0 = wp(0, rt, ct, ldw);
    const float* wb1 = NWM > 1 ? wp(1, rt, ct, ldw) : wb0;
    for (int k0 = 0; k0 < K; k0 += 16) {
        const u32x2 av = *(const u32x2*)(arow + k0 + ak);
        const f16x4 ah = __builtin_bit_cast(f16x4, av);
#pragma unroll
        for (int i = 0; i < 4; ++i) As[ak + i][tid >> 2] = (float)ah[i] * (kscale ? kscale[k0 + ak + i] : 1.f);
        {
            const f32x4 wv = *(const f32x4*)(wb0 + (size_t)(k0 + (tid >> 4)) * ldw + (tid & 15) * 4);
            *(f32x4*)&Ws[0][tid >> 4][(tid & 15) * 4] = wv;
            if (NWM > 1) { const f32x4 wv1 = *(const f32x4*)(wb1 + (size_t)(k0 + (tid >> 4)) * ldw + (tid & 15) * 4); *(f32x4*)&Ws[NWM - 1][tid >> 4][(tid & 15) * 4] = wv1; }
        }
        __syncthreads();
#pragma unroll
        for (int k = 0; k < 16; ++k) {
            const f32x4 a = *(const f32x4*)&As[k][ty * 4];
#pragma unroll
            for (int w = 0; w < NWM; ++w) {
                const f32x4 b = *(const f32x4*)&Ws[w][k][tx * 4];
#pragma unroll
                for (int i = 0; i < 4; ++i)
#pragma unroll
                    for (int j = 0; j < 4; ++j) acc[w][i][j] += a[i] * b[j];
            }
        }
        __syncthreads();
    }
#pragma unroll
    for (int w = 0; w < NWM; ++w)
#pragma unroll
        for (int i = 0; i < 4; ++i)
#pragma unroll
            for (int j = 0; j < 4; ++j) T[w][ty * 4 + i][tx * 4 + j] = acc[w][i][j];
    __syncthreads();
    epi(T, rt, ct, tid);
}

struct RpPlain { const f16* A; int lda; int pad; DEVI const f16* operator()(int rt, int r) const { return A + (size_t)(rt * 64 + r) * lda; } };
struct WpPlain { const float* W; int ldw_; int pad; DEVI const float* operator()(int, int, int ct, int& ldw) const { ldw = ldw_; return W + ct * 64; } };
struct EpiQKVn {
    f16* proj; const float *g_naq, *g_nak, *g_gq, *g_gk;
    DEVI void operator()(float (*T)[64][65], int rt, int ct, int tid) const {
        const int row = tid >> 2, q4 = tid & 3, grow = rt * 64 + row, hs = ct;
        float v[16];
#pragma unroll
        for (int i = 0; i < 16; ++i) v[i] = T[0][row][q4 * 16 + i];
        const float* g = nullptr; bool rope = false; float sc = 1.f;
        if (hs < 8) { g = g_naq; sc = C2; } else if (hs < 16) { g = g_nak; } else if (hs < 24) { } else if (hs < 32) { g = g_gq; rope = true; sc = C2; } else if (hs < 34) { g = g_gk; rope = true; }
        if (g) {
            float ssq = 0.f;
#pragma unroll
            for (int i = 0; i < 16; ++i) ssq += v[i] * v[i];
            ssq += __shfl_xor(ssq, 1); ssq += __shfl_xor(ssq, 2);
            const float rstd = rsqrtf(ssq * (1.f / 64.f) + EPS);
#pragma unroll
            for (int i = 0; i < 16; ++i) v[i] = v[i] * rstd * g[q4 * 16 + i];
        }
        if (rope) {
            const int t = grow & (SEQ - 1), pos = (q4 < 2) ? (t >> 6) : (t & 63);
#pragma unroll
            for (int i = 0; i < 8; ++i) { const int j = (q4 & 1) * 8 + i; const float c = g_rope.c[pos][j], s = g_rope.s[pos][j]; const float x0 = v[2 * i], x1 = v[2 * i + 1]; v[2 * i] = x0 * c - x1 * s; v[2 * i + 1] = x0 * s + x1 * c; }
        }
        f16* o = proj + (size_t)grow * INW + hs * 64 + q4 * 16;
#pragma unroll
        for (int i = 0; i < 16; ++i) o[i] = (f16)(v[i] * sc);
    }
};

__global__ __launch_bounds__(256) void k_mixnorm(const f16* __restrict__ att, const float* __restrict__ ga, const float* __restrict__ gb, f16* __restrict__ mixed) {
    const int lane = threadIdx.x & 63, wave = threadIdx.x >> 6; const int row = blockIdx.x * 4 + wave;
    const u32x4* a = (const u32x4*)(att + (size_t)row * MIXW + lane * 16);
    float v[16]; h8_to_f(a[0], v); h8_to_f(a[1], v + 8);
    float s = 0.f;
#pragma unroll
    for (int i = 0; i < 16; ++i) s += v[i] * v[i];
#pragma unroll
    for (int o = 1; o < 32; o <<= 1) s += __shfl_xor(s, o);
    const float rstd = rsqrtf(s * (1.f / 512.f) + EPS);
    const float* g = (lane < 32 ? ga : gb) + (lane & 31) * 16;
    u32x4 w0, w1;
    w0.x = pk_h2(v[0] * rstd * g[0], v[1] * rstd * g[1]); w0.y = pk_h2(v[2] * rstd * g[2], v[3] * rstd * g[3]); w0.z = pk_h2(v[4] * rstd * g[4], v[5] * rstd * g[5]); w0.w = pk_h2(v[6] * rstd * g[6], v[7] * rstd * g[7]);
    w1.x = pk_h2(v[8] * rstd * g[8], v[9] * rstd * g[9]); w1.y = pk_h2(v[10] * rstd * g[10], v[11] * rstd * g[11]); w1.z = pk_h2(v[12] * rstd * g[12], v[13] * rstd * g[13]); w1.w = pk_h2(v[14] * rstd * g[14], v[15] * rstd * g[15]);
    u32x4* o = (u32x4*)(mixed + (size_t)row * MIXW + lane * 16); o[0] = w0; o[1] = w1;
}
struct EpiOutn {
    const float* x; float* out; f16* h16;
    DEVI void operator()(float (*T)[64][65], int rt, int ct, int tid) const {
        const int row = tid >> 2, q4 = tid & 3; const size_t off = (size_t)(rt * 64 + row) * DM + ct * 64 + q4 * 16;
#pragma unroll
        for (int i = 0; i < 16; ++i) { const float h = x[off + i] + T[0][row][q4 * 16 + i]; out[off + i] = h; h16[off + i] = (f16)h; }
    }
};

struct RpGather { const f16* H; const int* idx; DEVI const f16* operator()(int rt, int r) const { const int panel = rt >> 2, slot = (rt & 3) * 64 + r, b = panel >> 4; return H + ((size_t)b * SEQ + idx[panel * CAP + slot]) * DM; } };
struct WpGU { const float *Wg, *Wu; DEVI const float* operator()(int w, int rt, int ct, int& ldw) const { const int e = (rt >> 2) & 15; ldw = DEXP; return (w ? Wu : Wg) + (size_t)e * DM * DEXP + ct * 64; } };
struct EpiActn {
    f16* act; const float* rss;
    DEVI void operator()(float (*T)[64][65], int rt, int ct, int tid) const {
        const int row = tid >> 2, q4 = tid & 3; const size_t prow = (size_t)rt * 64 + row; const float rs = rss[prow];
        f16* o = act + prow * DEXP + ct * 64 + q4 * 16;
#pragma unroll
        for (int i = 0; i < 16; ++i) { const float g = T[0][row][q4 * 16 + i] * rs, u = T[1][row][q4 * 16 + i] * rs; o[i] = (f16)(g / (1.f + __expf(-g)) * u); }
    }
};
struct WpDown { const float* Wd; DEVI const float* operator()(int, int rt, int ct, int& ldw) const { const int e = (rt >> 2) & 15; ldw = DM; return Wd + (size_t)e * DEXP * DM + ct * 64; } };
struct EpiYn {
    f16* y; const float* gate;
    DEVI void operator()(float (*T)[64][65], int rt, int ct, int tid) const {
        const int row = tid >> 2, q4 = tid & 3; const size_t prow = (size_t)rt * 64 + row; const float gt = gate[prow];
        f16* o = y + prow * DM + ct * 64 + q4 * 16;
#pragma unroll
        for (int i = 0; i < 16; ++i) o[i] = (f16)(T[0][row][q4 * 16 + i] * gt);
    }
};

__global__ __launch_bounds__(64) void k_nattn_gqa(const f16* __restrict__ proj, f16* __restrict__ att, float* __restrict__ ssqp) {
    __shared__ float Ks[64][64];
    __shared__ float Vs[64][64];
    const int t = threadIdx.x, qi = blockIdx.x * 64 + t, h = blockIdx.y, b = blockIdx.z, kvh = h >> 2;
    const size_t row = (size_t)b * SEQ + qi;
    float q[64], o[64];
    { const u32x4* qp = (const u32x4*)(proj + row * INW + C_GQ + h * 64);
#pragma unroll
      for (int c = 0; c < 8; ++c) h8_to_f(qp[c], q + 8 * c); }
#pragma unroll
    for (int d = 0; d < 64; ++d) o[d] = 0.f;
    float m = -1e30f, l = 0.f;
    for (int kt = 0; kt < SEQ / 64; ++kt) {
        __syncthreads();
#pragma unroll
        for (int c = 0; c < 8; ++c) {
            const int chunk = c * 64 + t, key = chunk >> 3, part = chunk & 7;
            const size_t krow = (size_t)b * SEQ + kt * 64 + key;
            float f[8];
            h8_to_f(*(const u32x4*)(proj + krow * INW + C_GK + kvh * 64 + part * 8), f);
#pragma unroll
            for (int i = 0; i < 8; ++i) Ks[key][part * 8 + i] = f[i];
            h8_to_f(*(const u32x4*)(proj + krow * INW + C_GV + kvh * 64 + part * 8), f);
#pragma unroll
            for (int i = 0; i < 8; ++i) Vs[key][part * 8 + i] = f[i];
        }
        __syncthreads();
        for (int j = 0; j < 64; ++j) {
            float s = 0.f;
#pragma unroll
            for (int d = 0; d < 64; ++d) s += q[d] * Ks[j][d];
            if (s > m) { const float a = exp2f(m - s); l *= a;
#pragma unroll
                for (int d = 0; d < 64; ++d) o[d] *= a;
                m = s; }
            const float p = exp2f(s - m); l += p;
#pragma unroll
            for (int d = 0; d < 64; ++d) o[d] += p * Vs[j][d];
        }
    }
    const float inv = 1.f / l; float ssq = 0.f;
    f16* op = att + row * MIXW + 512 + h * 64;
#pragma unroll
    for (int d = 0; d < 64; ++d) { const f16 hv = (f16)(o[d] * inv); op[d] = hv; const float r = (float)hv; ssq += r * r; }
    ssqp[row * 16 + 8 + h] = ssq;
}
__global__ __launch_bounds__(64) void k_nattn_na(const f16* __restrict__ proj, const float* __restrict__ rpb, f16* __restrict__ att, float* __restrict__ ssqp) {
    const int c = threadIdx.x, r = blockIdx.x, h = blockIdx.y, b = blockIdx.z;
    const size_t row = (size_t)b * SEQ + r * GRIDW + c;
    int rs = r - 4; rs = rs < 0 ? 0 : (rs > GROWS - 8 ? GROWS - 8 : rs);
    int cs = c - 8; cs = cs < 0 ? 0 : (cs > GRIDW - 16 ? GRIDW - 16 : cs);
    float q[64], o[64];
    { const u32x4* qp = (const u32x4*)(proj + row * INW + C_NAQ + h * 64);
#pragma unroll
      for (int cc = 0; cc < 8; ++cc) h8_to_f(qp[cc], q + 8 * cc); }
#pragma unroll
    for (int d = 0; d < 64; ++d) o[d] = 0.f;
    float m = -1e30f, l = 0.f;
    for (int kr = rs; kr < rs + 8; ++kr)
        for (int kc = cs; kc < cs + 16; ++kc) {
            const size_t krow = (size_t)b * SEQ + kr * GRIDW + kc;
            const u32x4* kp = (const u32x4*)(proj + krow * INW + C_NAK + h * 64);
            float s = 0.f;
#pragma unroll
            for (int cc = 0; cc < 8; ++cc) { float f[8]; h8_to_f(kp[cc], f);
#pragma unroll
                for (int i = 0; i < 8; ++i) s += q[8 * cc + i] * f[i]; }
            s += rpb[(h * 15 + (kr - r + 7)) * 31 + (kc - c + 15)] * LOG2E;
            if (s > m) { const float a = exp2f(m - s); l *= a;
#pragma unroll
                for (int d = 0; d < 64; ++d) o[d] *= a;
                m = s; }
            const float p = exp2f(s - m); l += p;
            const u32x4* vp = (const u32x4*)(proj + krow * INW + C_NAV + h * 64);
#pragma unroll
            for (int cc = 0; cc < 8; ++cc) { float f[8]; h8_to_f(vp[cc], f);
#pragma unroll
                for (int i = 0; i < 8; ++i) o[8 * cc + i] += p * f[i]; }
        }
    const float inv = 1.f / l; float ssq = 0.f;
    f16* op = att + row * MIXW + h * 64;
#pragma unroll
    for (int d = 0; d < 64; ++d) { const f16 hv = (f16)(o[d] * inv); op[d] = hv; const float rr = (float)hv; ssq += rr * rr; }
    ssqp[row * 16 + h] = ssq;
}

__global__ __launch_bounds__(512) void k_router(const float* __restrict__ h, const float* __restrict__ g2, const float* __restrict__ wr, float* __restrict__ aff, float* __restrict__ rstd2) {
    __shared__ f32x4 wr4[DM * 4];
    const int tid = threadIdx.x, lane = tid & 63, wave = tid >> 6;
    for (int i = tid; i < DM * 4; i += 512) { const int k = i >> 2, c4 = i & 3; const f32x4 w = ((const f32x4*)wr)[i] * g2[k]; wr4[k * 4 + (c4 ^ ((k >> 2) & 3))] = w; }
    __syncthreads();
    const int sw = (lane >> 2) & 3;
    for (int r = 0; r < 16; ++r) {
        const int t = blockIdx.x * 128 + wave * 16 + r;
        const float* hrow = h + (size_t)t * DM;
        float ssq = 0.f;
        float lg[16];
#pragma unroll
        for (int e = 0; e < 16; ++e) lg[e] = 0.f;
#pragma unroll 2
        for (int i = 0; i < 16; ++i) {
            const int k = lane + 64 * i; const float hv = hrow[k]; ssq += hv * hv;
#pragma unroll
            for (int c4 = 0; c4 < 4; ++c4) { const f32x4 w = wr4[k * 4 + (c4 ^ sw)]; lg[4 * c4 + 0] += hv * w.x; lg[4 * c4 + 1] += hv * w.y; lg[4 * c4 + 2] += hv * w.z; lg[4 * c4 + 3] += hv * w.w; }
        }
        const float rs = rsqrtf(wave_sum(ssq) * (1.f / DM) + EPS);
        float mx = -1e30f;
#pragma unroll
        for (int e = 0; e < 16; ++e) { lg[e] = wave_sum(lg[e]) * rs; mx = fmaxf(mx, lg[e]); }
        float sum = 0.f;
#pragma unroll
        for (int e = 0; e < 16; ++e) { lg[e] = __expf(lg[e] - mx); sum += lg[e]; }
        float mine = 0.f;
#pragma unroll
        for (int e = 0; e < 16; ++e) mine = (lane == e) ? lg[e] : mine;
        const int b = t >> 11, tt = t & (SEQ - 1);
        if (lane < 16) aff[((size_t)b * NEXP + lane) * SEQ + tt] = mine / sum;
        if (lane == 0) rstd2[t] = rs;
    }
}

DEVI int block_sum512(int v, int* red, int tid) {
    const int lane = tid & 63, wave = tid >> 6;
#pragma unroll
    for (int o = 1; o < 64; o <<= 1) v += __shfl_xor(v, o);
    if (lane == 0) red[wave] = v;
    __syncthreads();
    int s = 0;
#pragma unroll
    for (int w = 0; w < 8; ++w) s += red[w];
    return s;
}
DEVI int block_excl_scan512(int v, int* red, int tid) {
    const int lane = tid & 63, wave = tid >> 6;
    int inc = v;
#pragma unroll
    for (int o = 1; o < 64; o <<= 1) { const int n = __shfl_up(inc, o); if (lane >= o) inc += n; }
    if (lane == 63) red[wave] = inc;
    __syncthreads();
    int base = 0;
#pragma unroll
    for (int w = 0; w < 8; ++w) base += (w < wave) ? red[w] : 0;
    return base + inc - v;
}
__global__ __launch_bounds__(512) void k_topk(const float* __restrict__ aff, const float* __restrict__ rstd2, int* __restrict__ idx, float* __restrict__ rss, float* __restrict__ gate, short* __restrict__ inv) {
    __shared__ int red[4][8];
    const int tid = threadIdx.x, be = blockIdx.x, b = be >> 4, e = be & 15;
    const f32x4 a4 = ((const f32x4*)(aff + (size_t)be * SEQ))[tid];
    const float av[4] = {a4.x, a4.y, a4.z, a4.w};
    unsigned bits[4];
#pragma unroll
    for (int j = 0; j < 4; ++j) bits[j] = __float_as_uint(av[j]);
    unsigned lo = 0u, hi = 0x7f800000u;
    int it = 0;
    while (lo < hi) {
        const unsigned mid = lo + ((hi - lo + 1u) >> 1);
        int c = 0;
#pragma unroll
        for (int j = 0; j < 4; ++j) c += (bits[j] >= mid) ? 1 : 0;
        const int tot = block_sum512(c, red[it & 1], tid);
        if (tot >= CAP) lo = mid; else hi = mid - 1u;
        ++it;
    }
    const unsigned theta = lo;
    int cgt = 0, ceq = 0;
#pragma unroll
    for (int j = 0; j < 4; ++j) { cgt += (bits[j] > theta) ? 1 : 0; ceq += (bits[j] == theta) ? 1 : 0; }
    const int ngt = block_sum512(cgt, red[2], tid);
    const int need = CAP - ngt;
    int eqr = block_excl_scan512(ceq, red[3], tid);
    int sel[4]; int csel = 0;
#pragma unroll
    for (int j = 0; j < 4; ++j) { const bool eq = bits[j] == theta; sel[j] = (bits[j] > theta || (eq && eqr < need)) ? 1 : 0; eqr += eq ? 1 : 0; csel += sel[j]; }
    __syncthreads();
    int slot = block_excl_scan512(csel, red[0], tid);
#pragma unroll
    for (int j = 0; j < 4; ++j) {
        const int t = 4 * tid + j;
        short s = -1;
        if (sel[j]) { s = (short)slot; idx[be * CAP + slot] = t; gate[be * CAP + slot] = av[j]; rss[be * CAP + slot] = rstd2[b * SEQ + t]; ++slot; }
        inv[((size_t)b * SEQ + t) * NEXP + e] = s;
    }
}

__global__ __launch_bounds__(256) void k_combine(float* __restrict__ out, const f16* __restrict__ y, const short* __restrict__ inv) {
    const int lane = threadIdx.x & 63, wave = threadIdx.x >> 6; const int row = blockIdx.x * 4 + wave, b = row >> 11;
    f32x4* orow = (f32x4*)(out + (size_t)row * DM) + lane;
    f32x4 v[4];
#pragma unroll
    for (int j = 0; j < 4; ++j) v[j] = orow[64 * j];
    const short* iv = inv + (size_t)row * NEXP;
    for (int e = 0; e < NEXP; ++e) {
        const int s = iv[e];
        if (s >= 0) {
            const u32x2* yr = (const u32x2*)(y + ((size_t)(b * NEXP + e) * CAP + s) * DM) + lane;
#pragma unroll
            for (int j = 0; j < 4; ++j) { const f16x4 hh = __builtin_bit_cast(f16x4, yr[64 * j]); v[j].x += (float)hh[0]; v[j].y += (float)hh[1]; v[j].z += (float)hh[2]; v[j].w += (float)hh[3]; }
        }
    }
#pragma unroll
    for (int j = 0; j < 4; ++j) orow[64 * j] = v[j];
}


#define LAS __attribute__((address_space(3)))
#define GAS __attribute__((address_space(1)))
#define WAIT_V(n) asm volatile("s_waitcnt vmcnt(" #n ")" ::: "memory")
#define WAIT_L(n) asm volatile("s_waitcnt lgkmcnt(" #n ")" ::: "memory")
#define SBAR_RAW __builtin_amdgcn_s_barrier()
#define SCHED0 __builtin_amdgcn_sched_barrier(0)
DEVI int lane_id_v() { int l; asm volatile("v_mbcnt_lo_u32_b32 %0, -1, 0\n\tv_mbcnt_hi_u32_b32 %0, -1, %0" : "=v"(l)); return l; }

namespace pg8 {
constexpr int BM = 256, BK = 64, HALF = 128, HTB = HALF * BK * 2, STAGE_BYTES = 8 * HTB;
__host__ __device__ __forceinline__ int lds_byte(int r, int c) { const int st = (r >> 4) * 2 + (c >> 5), rr = r & 15, cc = c & 31, ob = rr * 64 + cc * 2; return st * 1024 + (ob ^ (((ob >> 9) & 1) << 5)); }
__host__ __device__ __forceinline__ void stage_rc(int b, int& R, int& C) { const int st = b / 1024, sb = b % 1024, swz = sb ^ (((sb >> 9) & 1) << 5); R = (st >> 1) * 16 + swz / 64; C = (st & 1) * 32 + (swz % 64) / 2; }
__host__ __device__ __forceinline__ int sigma_inv(int cl) { return 128 * ((cl >> 5) & 1) + 32 * (cl >> 6) + 16 * ((cl >> 2) & 1) + 4 * ((cl >> 3) & 3) + (cl & 3); }

struct Unit { int pm, pn, aux; };

template <class Epi, class Sched, bool ALIGN_EPI, bool FP8>
DEVI void gemm_phase(LAS unsigned char* lds, const int K, const Sched& S, const Epi& E, const int wid) {
    const int lane = lane_id_v(), tid = wid * 64 + lane, wr = wid >> 2, wc = wid & 3, fr = lane & 15, fq = lane >> 4;
    const int nt = K * (FP8 ? 1 : 2) / 128;
    const int RBA = S.a_pitch(), RBB = S.b_pitch();
    const size_t kstepA = S.a_kstep(), kstepB = S.b_kstep();
    int sR[2], sC[2];
    unsigned voffB[2];
#pragma unroll
    for (int i = 0; i < 2; ++i) { stage_rc(tid * 16 + i * 8192, sR[i], sC[i]); voffB[i] = (unsigned)(sR[i] * RBB + sC[i] * 2); }
    const size_t hstep = (size_t)HALF * RBB;
    const unsigned ldsw = (unsigned)wid * 1024u;
    const int aoff = lds_byte(wr * 64 + fr, fq * 8), boff = lds_byte(wc * 32 + fr, fq * 8);
    LAS unsigned char* const ldsA = lds + aoff; LAS unsigned char* const ldsB = lds + 4 * HTB + boff;
#define PG8_SA(b, h) (((b) * 2 + (h)) * HTB)
#define PG8_SB(b, h) ((4 + (b) * 2 + (h)) * HTB)
#define PG8_STAGE(bufoff, gbase, v0, v1) do { \
        __builtin_amdgcn_global_load_lds((const unsigned*)((const char*)(gbase) + (v0)), (LAS unsigned*)(lds + (bufoff) + ldsw), 16, 0, 0); \
        __builtin_amdgcn_global_load_lds((const unsigned*)((const char*)(gbase) + (v1)), (LAS unsigned*)(lds + (bufoff) + ldsw + 8192), 16, 0, 0); } while (0)
#define PG8_LDF(base_, off_) (*(const LAS f16x8*)((base_) + (off_)))
#define PG8_LDA(dst, b, h) do { _Pragma("unroll") for (int m = 0; m < 4; ++m) { \
        if constexpr (FP8) dst##8[m] = PG8_CAT(PG8_LDF(ldsA, PG8_SA(b, h) + m * 2048), PG8_LDF(ldsA, PG8_SA(b, h) + m * 2048 + 1024)); \
        else { _Pragma("unroll") for (int k = 0; k < 2; ++k) dst[m][k] = PG8_LDF(ldsA, PG8_SA(b, h) + m * 2048 + k * 1024); } } } while (0)
#define PG8_LDB(dst, b, h) do { _Pragma("unroll") for (int n = 0; n < 2; ++n) { \
        if constexpr (FP8) dst##8[n] = PG8_CAT(PG8_LDF(ldsB, PG8_SB(b, h) - 4 * HTB + n * 2048), PG8_LDF(ldsB, PG8_SB(b, h) - 4 * HTB + n * 2048 + 1024)); \
        else { _Pragma("unroll") for (int k = 0; k < 2; ++k) dst[n][k] = PG8_LDF(ldsB, PG8_SB(b, h) - 4 * HTB + n * 2048 + k * 1024); } } } while (0)
#define PG8_CAT(lo_, hi_) __builtin_shufflevector(__builtin_bit_cast(i32x4, lo_), __builtin_bit_cast(i32x4, hi_), 0, 1, 2, 3, 4, 5, 6, 7)
#define PG8_MMA(ai, bj, At, Bt) do { __builtin_amdgcn_s_setprio(1); _Pragma("unroll") for (int m = 0; m < 4; ++m) _Pragma("unroll") for (int n = 0; n < 2; ++n) { \
        if constexpr (FP8) asm volatile("v_mfma_f32_16x16x128_f8f6f4 %0, %1, %2, %0" : "+v"(acc[ai][bj][m][n]) : "v"(Bt##8[n]), "v"(At##8[m]));   \
        else { _Pragma("unroll") for (int k = 0; k < 2; ++k) acc[ai][bj][m][n] = __builtin_amdgcn_mfma_f32_16x16x32_f16(Bt[n][k], At[m][k], acc[ai][bj][m][n], 0, 0, 0); } } \
        __builtin_amdgcn_s_setprio(0); } while (0)
    Unit cur, nxt; int ui = 0;
    if (!S.next(0, cur)) return;
    f32x4 acc[2][2][4][2];
#pragma unroll
    for (int a = 0; a < 2; ++a)
#pragma unroll
        for (int b = 0; b < 2; ++b)
#pragma unroll
            for (int m = 0; m < 4; ++m)
#pragma unroll
                for (int n = 0; n < 2; ++n) acc[a][b][m][n] = (f32x4){0.f, 0.f, 0.f, 0.f};
    f16x8 At[4][2], B0[2][2], B1[2][2];
    const int one_scale = 0x7f7f7f7f;
    i32x8 At8[4], B08[2], B18[2];
    const char* cA = S.a_base(cur); const char* cB = S.b_base(cur);
    unsigned vA00, vA01, vA10, vA11, nA00, nA01, nA10, nA11;
    vA00 = S.a_off(cur, sR[0], sC[0] * 2); vA01 = S.a_off(cur, sR[1], sC[1] * 2);
    vA10 = S.a_off(cur, HALF + sR[0], sC[0] * 2); vA11 = S.a_off(cur, HALF + sR[1], sC[1] * 2);
    nA00 = vA00; nA01 = vA01; nA10 = vA10; nA11 = vA11;
    PG8_STAGE(PG8_SB(0, 0), cB, voffB[0], voffB[1]); PG8_STAGE(PG8_SB(0, 1), cB + hstep, voffB[0], voffB[1]); PG8_STAGE(PG8_SA(0, 0), cA, vA00, vA01); PG8_STAGE(PG8_SA(0, 1), cA, vA10, vA11);
    if (wr == 1) SBAR_RAW;
    WAIT_V(2); SBAR_RAW;
    PG8_STAGE(PG8_SB(1, 0), cB + kstepB, voffB[0], voffB[1]); PG8_STAGE(PG8_SA(1, 0), cA + kstepA, vA00, vA01); PG8_STAGE(PG8_SB(1, 1), cB + hstep + kstepB, voffB[0], voffB[1]);
    WAIT_V(6); SBAR_RAW;
    for (;;) {
        const bool has_next = S.next(ui + 1, nxt);
        const char* nA = has_next ? S.a_base(nxt) : cA; const char* nB = has_next ? S.b_base(nxt) : cB;
#pragma unroll 1
        for (int t = 0; t < nt; t += 2) {
            const bool last = (t == nt - 2);
            if (Epi::HAS_MID) { if (t == (nt >> 1)) E.mid(acc, cur, wr, wc, fr, fq); }
            if (Sched::GATHER) { if (last && has_next) {
                nA00 = S.a_off(nxt, sR[0], sC[0] * 2); nA01 = S.a_off(nxt, sR[1], sC[1] * 2);
                nA10 = S.a_off(nxt, HALF + sR[0], sC[0] * 2); nA11 = S.a_off(nxt, HALF + sR[1], sC[1] * 2); } }
            const char* a1 = cA + (size_t)(t + 1) * kstepA;
            const char* a2 = last ? nA : cA + (size_t)(t + 2) * kstepA; const char* b2 = last ? nB : cB + (size_t)(t + 2) * kstepB;
            const char* a3 = a2 + kstepA; const char* b3 = b2 + kstepB;
            const unsigned w00 = (Sched::GATHER && last) ? nA00 : vA00, w01 = (Sched::GATHER && last) ? nA01 : vA01, w10 = (Sched::GATHER && last) ? nA10 : vA10, w11 = (Sched::GATHER && last) ? nA11 : vA11;
            PG8_LDB(B0, 0, 0); PG8_LDB(B1, 0, 1); SCHED0; PG8_LDA(At, 0, 0); PG8_STAGE(PG8_SA(1, 1), a1, vA10, vA11);
            WAIT_V(8); WAIT_L(0); SBAR_RAW; PG8_MMA(0, 0, At, B0); PG8_MMA(0, 1, At, B1); SBAR_RAW; SCHED0;
            PG8_LDA(At, 0, 1); PG8_STAGE(PG8_SB(0, 0), b2, voffB[0], voffB[1]); PG8_STAGE(PG8_SB(0, 1), b2 + hstep, voffB[0], voffB[1]); PG8_STAGE(PG8_SA(0, 0), a2, w00, w01);
            WAIT_V(8); WAIT_L(0); SBAR_RAW; PG8_MMA(1, 0, At, B0); PG8_MMA(1, 1, At, B1); SBAR_RAW; SCHED0;
            PG8_LDB(B0, 1, 0); PG8_LDB(B1, 1, 1); SCHED0; PG8_LDA(At, 1, 0); PG8_STAGE(PG8_SA(0, 1), a2, w10, w11);
            WAIT_V(8); WAIT_L(0); SBAR_RAW; PG8_MMA(0, 0, At, B0); PG8_MMA(0, 1, At, B1); SBAR_RAW; SCHED0;
            PG8_LDA(At, 1, 1); PG8_STAGE(PG8_SB(1, 0), b3, voffB[0], voffB[1]); PG8_STAGE(PG8_SB(1, 1), b3 + hstep, voffB[0], voffB[1]); PG8_STAGE(PG8_SA(1, 0), a3, w00, w01);
            WAIT_V(8); WAIT_L(0); SBAR_RAW; PG8_MMA(1, 0, At, B0); PG8_MMA(1, 1, At, B1); SBAR_RAW; SCHED0;
        }
        if constexpr (ALIGN_EPI) { if (wr == 0) SBAR_RAW; }
        if constexpr (FP8) asm volatile("s_nop 15\n\ts_nop 7" ::: "memory");
        E(acc, cur, wr, wc, fr, fq);
        if (!has_next) break;
#pragma unroll
        for (int a = 0; a < 2; ++a)
#pragma unroll
            for (int b = 0; b < 2; ++b)
#pragma unroll
                for (int m = 0; m < 4; ++m)
#pragma unroll
                    for (int n = 0; n < 2; ++n) acc[a][b][m][n] = (f32x4){0.f, 0.f, 0.f, 0.f};
        cur = nxt; cA = nA; cB = nB; ++ui;
        if (Sched::GATHER) { vA00 = nA00; vA01 = nA01; vA10 = nA10; vA11 = nA11; }
        if constexpr (ALIGN_EPI) { if (wr == 1) SBAR_RAW; }
    }
    WAIT_V(0);
    if constexpr (!ALIGN_EPI) { if (wr == 0) SBAR_RAW; }
    SBAR_RAW;
#undef PG8_SA
#undef PG8_SB
#undef PG8_STAGE
#undef PG8_LDA
#undef PG8_LDF
#undef PG8_LDB
#undef PG8_MMA
#undef PG8_CAT
}

constexpr int NXCD = 8, WGM = 8;
struct SchedDense {
    static constexpr bool GATHER = false;
    const char* A; const char* Bt; int nM, nN, nwg, G, c; size_t tstep;
    DEVI void init(const void* A_, const void* Bt_, int M, int N, int K, int G_, int c_) { A = (const char*)A_; Bt = (const char*)Bt_; nM = M / BM; nN = N / BM; nwg = nM * nN; G = G_; c = c_; tstep = (size_t)BM * K * 2; }
    DEVI bool next(int i, Unit& u) const {
        const long L = (long)i * G + c; if (L >= nwg) return false;
        int wgid = (int)L; { const int q = nwg / NXCD, r = nwg % NXCD, xcd = wgid % NXCD, off = wgid / NXCD; wgid = (xcd < r ? xcd * (q + 1) : r * (q + 1) + (xcd - r) * q) + off; }
        const int nig = WGM * nN, gid = wgid / nig, fm = gid * WGM, gsz = (nM - fm) < WGM ? (nM - fm) : WGM;
        u.pm = fm + ((wgid % nig) % gsz); u.pn = (wgid % nig) / gsz; u.aux = i; return true;
    }
    DEVI const char* a_base(const Unit& u) const { return A + (size_t)u.pm * tstep; }
    DEVI const char* b_base(const Unit& u) const { return Bt + (size_t)u.pn * tstep; }
    DEVI unsigned a_off(const Unit&, int r, int cb) const { return (unsigned)(r * (int)(tstep / BM) + cb); }
    DEVI int a_pitch() const { return (int)(tstep / BM); } DEVI int b_pitch() const { return (int)(tstep / BM); } DEVI size_t a_kstep() const { return 128; } DEVI size_t b_kstep() const { return 128; }
};
struct SchedE1 {
    static constexpr bool GATHER = true;
    const char* H; const char* W1; const LAS unsigned short* lidx; int G, vcu;
    DEVI int batch_of() const { if (G == 256) { const int x = vcu >> 5, y = vcu & 31; return (x & 3) * 4 + (y & 3); } return vcu & 15; }
    DEVI bool next(int i, Unit& u) const {
        int ep;
        if (G == 256) { if (i >= 22) return false; const int x = vcu >> 5, y = vcu & 31; ep = 16 * i + (x >> 2) * 8 + (y >> 2); }
        else { ep = (vcu >> 4) + i * (G >> 4); if (ep >= 352) return false; }
        const int e = ep / 22; u.pn = ep - e * 22; u.pm = batch_of() * NEXP + e; u.aux = e; return true;
    }
    DEVI const char* a_base(const Unit& u) const { return H + (size_t)(u.pm >> 4) * SEQ * DM; }
    DEVI const char* b_base(const Unit& u) const { return W1 + ((size_t)u.aux * 5632 + (size_t)u.pn * 256) * DM; }
    DEVI unsigned a_off(const Unit& u, int r, int cb) const { return (unsigned)((int)lidx[u.aux * CAP + r] * DM + cb); }
    DEVI int a_pitch() const { return DM; } DEVI int b_pitch() const { return 128; } DEVI size_t a_kstep() const { return 128; } DEVI size_t b_kstep() const { return 32768; }
};
struct SchedE2 {
    static constexpr bool GATHER = false;
    const char* ACT; const char* W2; int G, vcu;
    DEVI bool next(int i, Unit& u) const {
        const long L = (long)i * G + vcu; if (L >= 1024) return false;
        const int e = (int)(L >> 6), q = (int)(L & 63); u.pm = (q >> 2) * NEXP + e; u.pn = q & 3; u.aux = e; return true;
    }
    DEVI const char* a_base(const Unit& u) const { return ACT + (size_t)u.pm * CAP * DEXP; }
    DEVI const char* b_base(const Unit& u) const { return W2 + ((size_t)u.aux * DM + (size_t)u.pn * 256) * DEXP; }
    DEVI unsigned a_off(const Unit&, int r, int cb) const { return (unsigned)((cb >> 5) * 8192 + r * 32 + (cb & 31)); }
    DEVI int a_pitch() const { return 128; } DEVI int b_pitch() const { return 128; } DEVI size_t a_kstep() const { return 32768; } DEVI size_t b_kstep() const { return 32768; }
};

typedef f32x4 AccT[2][2][4][2];
DEVI u32x4 pack8(const f32x4 a, const f32x4 b) { u32x4 w; w.x = pk_h2(a[0], a[1]); w.y = pk_h2(a[2], a[3]); w.z = pk_h2(b[0], b[1]); w.w = pk_h2(b[2], b[3]); return w; }

struct EpiQKV {
    static constexpr bool HAS_MID = false;
    f16* proj; const float *g_naq, *g_nak, *g_gq, *g_gk;
    DEVI void mid(AccT&, const Unit&, int, int, int, int) const {}
    DEVI void operator()(const AccT& acc, const Unit& u, int wr, int wc, int fr, int fq) const {
        const int hs = u.pn * 4 + wc;
        const float* g = nullptr; bool rope = false; float sc = 1.f;
        if (hs < 8) { g = g_naq; sc = C2; } else if (hs < 16) { g = g_nak; } else if (hs < 24) { } else if (hs < 32) { g = g_gq; rope = true; sc = C2; } else if (hs < 34) { g = g_gk; rope = true; }
        f32x4 gv[2][2];
#pragma unroll
        for (int bj = 0; bj < 2; ++bj)
#pragma unroll
            for (int n = 0; n < 2; ++n) gv[bj][n] = g ? *(const f32x4*)(g + 32 * bj + 8 * fq + 4 * n) : (f32x4){1.f, 1.f, 1.f, 1.f};
#pragma unroll
        for (int ai = 0; ai < 2; ++ai)
#pragma unroll
            for (int m = 0; m < 4; ++m) {
                const int row = u.pm * BM + ai * HALF + wr * 64 + m * 16 + fr;
                f32x4 v[2][2];
#pragma unroll
                for (int bj = 0; bj < 2; ++bj)
#pragma unroll
                    for (int n = 0; n < 2; ++n) v[bj][n] = acc[ai][bj][m][n];
                if (g) {
                    float ssq = 0.f;
#pragma unroll
                    for (int bj = 0; bj < 2; ++bj)
#pragma unroll
                        for (int n = 0; n < 2; ++n) ssq += (v[bj][n][0] * v[bj][n][0] + v[bj][n][1] * v[bj][n][1]) + (v[bj][n][2] * v[bj][n][2] + v[bj][n][3] * v[bj][n][3]);
                    ssq += __shfl_xor(ssq, 16); ssq += __shfl_xor(ssq, 32);
                    const float rstd = rsqrtf(ssq * (1.f / 64.f) + EPS);
#pragma unroll
                    for (int bj = 0; bj < 2; ++bj)
#pragma unroll
                        for (int n = 0; n < 2; ++n) v[bj][n] = v[bj][n] * rstd * gv[bj][n];
                }
                if (rope) {
                    const int t = row & (SEQ - 1);
#pragma unroll
                    for (int bj = 0; bj < 2; ++bj) {
                        const int pos = bj ? (t & 63) : (t >> 6);
                        const f32x4 cc = *(const f32x4*)&g_rope.c[pos][4 * fq], ss = *(const f32x4*)&g_rope.s[pos][4 * fq];
#pragma unroll
                        for (int n = 0; n < 2; ++n) {
                            const float x0 = v[bj][n][0], x1 = v[bj][n][1], x2 = v[bj][n][2], x3 = v[bj][n][3];
                            v[bj][n][0] = x0 * cc[2 * n] - x1 * ss[2 * n]; v[bj][n][1] = x0 * ss[2 * n] + x1 * cc[2 * n];
                            v[bj][n][2] = x2 * cc[2 * n + 1] - x3 * ss[2 * n + 1]; v[bj][n][3] = x2 * ss[2 * n + 1] + x3 * cc[2 * n + 1];
                        }
                    }
                }
                {
                    const u32x4 d0 = pack8(v[0][0] * sc, v[0][1] * sc), d1 = pack8(v[1][0] * sc, v[1][1] * sc);
                    const bool lowr = fr < 8; u32x4 rcv, s1, s2;
#pragma unroll
                    for (int i = 0; i < 4; ++i) { const unsigned snd = lowr ? d1[i] : d0[i]; rcv[i] = (unsigned)__builtin_amdgcn_update_dpp(0, (int)snd, 0x128, 0xF, 0xF, true); s1[i] = lowr ? d0[i] : rcv[i]; s2[i] = lowr ? rcv[i] : d1[i]; }
                    f16* c0 = proj + (size_t)(row - fr + (fr & 7)) * INW + hs * 64 + 8 * fq + 32 * (fr >> 3);
                    *(u32x4*)c0 = s1; *(u32x4*)(c0 + (size_t)8 * INW) = s2;
                }
            }
    }
};
struct EpiOut {
    static constexpr bool HAS_MID = true;
    const f16* xn; const float* rms1; f16* h16; LAS f32x2* rab; const float* ssq; unsigned char* h8;
    const f16* wrt; float* part; float* ssq2p; unsigned* pcnt; float* aff; float* rstd2; volatile LAS unsigned* flag;
    DEVI void mid(AccT& acc, const Unit& u, int wr, int wc, int fr, int fq) const {
        LAS float* mine = (LAS float*)rab + (wr * 4 + wc) * 128;
        int lofs = (fq * 4) * MTOK + fr; asm volatile("" : "+v"(lofs));
        const float* sp0 = ssq + (size_t)u.pm * BM + wr * 64 + lofs;
#pragma unroll
        for (int g = 0; g < 8; ++g) { const int ai = g >> 2, m = g & 3;
            const float* sp = sp0 + ai * HALF + m * 16;
            float t = (sp[0] + sp[(size_t)MTOK]) + (sp[(size_t)2 * MTOK] + sp[(size_t)3 * MTOK]);
            { auto r_ = __builtin_amdgcn_permlane16_swap(__float_as_uint(t), __float_as_uint(t), false, false); t = __uint_as_float(r_[0]) + __uint_as_float(r_[1]); }
            auto r2 = __builtin_amdgcn_permlane32_swap(__float_as_uint(t), __float_as_uint(t), false, false);
            const float o_ = (fq < 2) ? __uint_as_float(r2[1]) : __uint_as_float(r2[0]);
            const float sa = (fq < 2) ? t : o_, sb = (fq < 2) ? o_ : t;
            const float ra = rsqrtf(sa * (1.f / 512.f) + EPS), rb = rsqrtf(sb * (1.f / 512.f) + EPS), ratio = ra / rb;
            if (fq == 0) mine[g * 16 + fr] = rb;
#pragma unroll
            for (int bj = 0; bj < 2; ++bj)
#pragma unroll
                for (int n = 0; n < 2; ++n) acc[ai][bj][m][n] = acc[ai][bj][m][n] * ratio;
            if (g & 1) SCHED0;
        }
    }
    DEVI void finalize(int pm, int tid) const {
        asm volatile("" : "+v"(tid));
        const int row = pm * BM + (tid >> 1), hf = tid & 1;
        f32x4 l0 = {0.f, 0.f, 0.f, 0.f}, l1 = l0, l2 = l0, l3 = l0; float sq = 0.f;
#pragma unroll
        for (int s8 = 0; s8 < 8; ++s8) { const int sl = hf * 8 + s8; const f32x4* p = (const f32x4*)(part + ((size_t)sl * MTOK + (row & ~15) + ((row & 3) << 2) + ((row >> 2) & 3)) * 16);
            l0 += p[0]; l1 += p[1]; l2 += p[2]; l3 += p[3]; sq += ssq2p[(size_t)sl * MTOK + row]; }
        float lg[16] = {l0[0], l0[1], l0[2], l0[3], l1[0], l1[1], l1[2], l1[3], l2[0], l2[1], l2[2], l2[3], l3[0], l3[1], l3[2], l3[3]};
        float other = __builtin_bit_cast(float, __builtin_amdgcn_update_dpp(0, __builtin_bit_cast(int, sq), 0xB1, 0xF, 0xF, true));
        sq = hf ? (other + sq) : (sq + other);
        const float rs = rsqrtf(sq * (1.f / DM) + EPS);
        float mx = -1e30f;
#pragma unroll
        for (int e = 0; e < 16; ++e) { const float o2 = __builtin_bit_cast(float, __builtin_amdgcn_update_dpp(0, __builtin_bit_cast(int, lg[e]), 0xB1, 0xF, 0xF, true));
            lg[e] = (hf ? (o2 + lg[e]) : (lg[e] + o2)) * rs; mx = fmaxf(mx, lg[e]); }
        float sum = 0.f;
#pragma unroll
        for (int e = 0; e < 16; ++e) { lg[e] = __expf(lg[e] - mx); sum += lg[e]; }
        const float inv = 1.f / sum; const int b = row >> 11, tt = row & (SEQ - 1);
#pragma unroll
        for (int e = 0; e < 16; ++e) if ((e >> 3) == hf) aff[((size_t)b * NEXP + e) * SEQ + tt] = lg[e] * inv;
        if (hf == 0) rstd2[row] = rs;
    }
    struct RowIn { u32x4 a, b; float rm; };
    DEVI void load_rg(RowIn& R, const Unit& u, int g, int wr, int wc, int fr, int fq) const {
        const int row = u.pm * BM + (g >> 2) * HALF + wr * 64 + (g & 3) * 16 + fr;
        const size_t off = (size_t)row * DM + u.pn * BM + wc * 64 + 8 * fq;
        R.a = *(const u32x4*)(xn + off); R.b = *(const u32x4*)(xn + off + 32); R.rm = rms1[row];
    }
    static DEVI void xres(const u32x4 w, float rm, f32x4& x0, f32x4& x1) { const f16x8 h = __builtin_bit_cast(f16x8, w);
        x0 = (f32x4){(float)h[0], (float)h[1], (float)h[2], (float)h[3]} * rm; x1 = (f32x4){(float)h[4], (float)h[5], (float)h[6], (float)h[7]} * rm; }
    DEVI void operator()(const AccT& acc, const Unit& u, int wr, int wc, int fr, int fq) const {
        const int slice = u.pn * 4 + wc;
        const f16* wb = wrt + (size_t)fr * DM + u.pn * BM + wc * 64 + 8 * fq;
        const f16x8 bh0 = *(const f16x8*)(wb), bh1 = *(const f16x8*)(wb + 32), bl0 = *(const f16x8*)(wb + (size_t)NEXP * DM), bl1 = *(const f16x8*)(wb + (size_t)NEXP * DM + 32);
        RowIn Ra, Rb, Rc, Rd;
        load_rg(Ra, u, 0, wr, wc, fr, fq); load_rg(Rb, u, 1, wr, wc, fr, fq); load_rg(Rc, u, 2, wr, wc, fr, fq);
#define EO_GROUP(g, R) do { const int ai = (g) >> 2, m = (g) & 3; \
            const int row16 = u.pm * BM + ai * HALF + wr * 64 + m * 16, row = row16 + fr; \
            const float rb = ((const LAS float*)rab)[(wr * 4 + wc) * 128 + (g) * 16 + fr]; \
            const size_t off = (size_t)row * DM + u.pn * BM + wc * 64 + 8 * fq; \
            f32x4 lg = {0.f, 0.f, 0.f, 0.f}; float sq = 0.f; u32x4 hi8s_[2]; \
            _Pragma("unroll") for (int bj = 0; bj < 2; ++bj) { \
                f32x4 xr0_, xr1_; xres(bj ? R.b : R.a, R.rm, xr0_, xr1_); \
                const f32x4 h0 = xr0_ + acc[ai][bj][m][0] * rb, h1 = xr1_ + acc[ai][bj][m][1] * rb; \
                const u32x4 hi8 = pack8(h0, h1); \
                hi8s_[bj] = hi8; \
                { u32x2 q; q.x = pk_f8x4(h0[0] * H_SCALE, h0[1] * H_SCALE, h0[2] * H_SCALE, h0[3] * H_SCALE); q.y = pk_f8x4(h1[0] * H_SCALE, h1[1] * H_SCALE, h1[2] * H_SCALE, h1[3] * H_SCALE); *(u32x2*)(h8 + off + 32 * bj) = q; } \
                const f16x8 hh = __builtin_bit_cast(f16x8, hi8); \
                const f32x4 d0 = {h0[0] - (float)hh[0], h0[1] - (float)hh[1], h0[2] - (float)hh[2], h0[3] - (float)hh[3]}, d1 = {h1[0] - (float)hh[4], h1[1] - (float)hh[5], h1[2] - (float)hh[6], h1[3] - (float)hh[7]}; \
                const f16x8 hl = __builtin_bit_cast(f16x8, pack8(d0, d1)); \
                lg = __builtin_amdgcn_mfma_f32_16x16x32_f16(hh, bj ? bh1 : bh0, lg, 0, 0, 0); \
                lg = __builtin_amdgcn_mfma_f32_16x16x32_f16(hh, bj ? bl1 : bl0, lg, 0, 0, 0); \
                lg = __builtin_amdgcn_mfma_f32_16x16x32_f16(hl, bj ? bh1 : bh0, lg, 0, 0, 0); \
                sq += ((h0[0] * h0[0] + h0[1] * h0[1]) + (h0[2] * h0[2] + h0[3] * h0[3])) + ((h1[0] * h1[0] + h1[1] * h1[1]) + (h1[2] * h1[2] + h1[3] * h1[3])); } \
            { const bool lowr_ = fr < 8; u32x4 rcv_, s1_, s2_;     \
              _Pragma("unroll") for (int i = 0; i < 4; ++i) { const unsigned snd_ = lowr_ ? hi8s_[1][i] : hi8s_[0][i]; rcv_[i] = (unsigned)__builtin_amdgcn_update_dpp(0, (int)snd_, 0x128, 0xF, 0xF, true); s1_[i] = lowr_ ? hi8s_[0][i] : rcv_[i]; s2_[i] = lowr_ ? rcv_[i] : hi8s_[1][i]; } \
              f16* c0_ = h16 + (size_t)(row16 + (fr & 7)) * DM + u.pn * BM + wc * 64 + 8 * fq + 32 * (fr >> 3); \
              *(u32x4*)c0_ = s1_; *(u32x4*)(c0_ + (size_t)8 * DM) = s2_; } \
            { auto r_ = __builtin_amdgcn_permlane16_swap(__float_as_uint(sq), __float_as_uint(sq), false, false); sq = __uint_as_float(r_[0]) + __uint_as_float(r_[1]); } \
            { auto r_ = __builtin_amdgcn_permlane32_swap(__float_as_uint(sq), __float_as_uint(sq), false, false); sq = __uint_as_float(r_[0]) + __uint_as_float(r_[1]); } \
            if (fq == 0) __hip_atomic_store(ssq2p + (size_t)slice * MTOK + row, sq, __ATOMIC_RELAXED, __HIP_MEMORY_SCOPE_AGENT);     \
            float* pp = part + ((size_t)slice * MTOK + row16 + fq) * 16 + fr;         \
            _Pragma("unroll") for (int r = 0; r < 4; ++r) __hip_atomic_store(pp + r * 64, lg[r], __ATOMIC_RELAXED, __HIP_MEMORY_SCOPE_AGENT); } while (0)
        load_rg(Rd, u, 3, wr, wc, fr, fq); SCHED0; EO_GROUP(0, Ra); SCHED0;
        load_rg(Ra, u, 4, wr, wc, fr, fq); SCHED0; EO_GROUP(1, Rb); SCHED0;
        load_rg(Rb, u, 5, wr, wc, fr, fq); SCHED0; EO_GROUP(2, Rc); SCHED0;
        load_rg(Rc, u, 6, wr, wc, fr, fq); SCHED0; EO_GROUP(3, Rd); SCHED0;
        load_rg(Rd, u, 7, wr, wc, fr, fq); SCHED0; EO_GROUP(4, Ra); SCHED0;
        EO_GROUP(5, Rb); SCHED0;
        EO_GROUP(6, Rc); SCHED0;
        EO_GROUP(7, Rd); SCHED0;
#undef EO_GROUP
        const int lane = fr + 16 * fq; const bool leader = (wr == 0 && wc == 0 && lane == 0);
        asm volatile("s_waitcnt vmcnt(0)" ::: "memory");
        __syncthreads();
        if (leader) {
            const unsigned old = __hip_atomic_fetch_add(pcnt + 64 * u.pm, 1u, __ATOMIC_RELAXED, __HIP_MEMORY_SCOPE_AGENT);
            const unsigned last = (old == 3u) ? 1u : 0u;
            if (last) { __builtin_amdgcn_fence(__ATOMIC_ACQUIRE, "agent"); asm volatile("s_waitcnt vmcnt(0)" ::: "memory"); }
            flag[2] = last;
        }
        __syncthreads();
        if (flag[2]) finalize(u.pm, (wr * 4 + wc) * 64 + lane);
        __syncthreads();
    }
};
struct EpiAct {
    static constexpr bool HAS_MID = false;
    unsigned char* act; const LAS float* lrss;
    DEVI void mid(AccT&, const Unit&, int, int, int, int) const {}
    DEVI void operator()(const AccT& acc, const Unit& u, int wr, int wc, int fr, int fq) const {
#pragma unroll
        for (int ai = 0; ai < 2; ++ai)
#pragma unroll
            for (int m = 0; m < 4; ++m) {
                const size_t prow = (size_t)u.pm * CAP + ai * HALF + wr * 64 + m * 16 + fr;
                const float rs = lrss[u.aux * CAP + ai * HALF + wr * 64 + m * 16 + fr] * (1.f / (H_SCALE * W_SCALE));
                f32x4 a[2];
                const f32x2 rs2 = {rs, rs}, rsn = {rs * -LOG2E, rs * -LOG2E}, rsa = {rs * A_SCALE, rs * A_SCALE}, one2 = {1.f, 1.f};
#pragma unroll
                for (int n = 0; n < 2; ++n)
#pragma unroll
                    for (int i = 0; i < 4; i += 2) {
                        const f32x2 ag = {acc[ai][0][m][n][i], acc[ai][0][m][n][i + 1]}, au = {acc[ai][1][m][n][i], acc[ai][1][m][n][i + 1]};
                        const f32x2 t = ag * rsn; f32x2 d = {__builtin_amdgcn_exp2f(t[0]), __builtin_amdgcn_exp2f(t[1])}; d = d + one2;
                        const f32x2 r = {__builtin_amdgcn_rcpf(d[0]), __builtin_amdgcn_rcpf(d[1])};
                        const f32x2 o = ((ag * rs2) * r) * (au * rsa);
                        a[n][i] = o[0]; a[n][i + 1] = o[1]; }
                u32x2 q; q.x = pk_f8x4(a[0][0], a[0][1], a[0][2], a[0][3]); q.y = pk_f8x4(a[1][0], a[1][1], a[1][2], a[1][3]);
                __builtin_nontemporal_store(q, (u32x2*)(act + ((size_t)u.pm * 22 + u.pn) * 32768 + (size_t)wc * 8192 + (size_t)(ai * HALF + wr * 64 + m * 16 + fr) * 32 + 8 * fq));
            }
    }
};
struct EpiY {
    static constexpr bool HAS_MID = false;
    f16* y; const float* gate;
    DEVI void mid(AccT&, const Unit&, int, int, int, int) const {}
    DEVI void operator()(const AccT& acc, const Unit& u, int wr, int wc, int fr, int fq) const {
        float gts[2][4];
#pragma unroll
        for (int ai = 0; ai < 2; ++ai)
#pragma unroll
            for (int m = 0; m < 4; ++m) gts[ai][m] = gate[(size_t)u.pm * CAP + ai * HALF + wr * 64 + m * 16 + fr];
        asm volatile("s_waitcnt vmcnt(0)" ::: "memory");
        const bool lowr = fr < 8; const int r8 = fr & 7, hb = fr >> 3;
#pragma unroll
        for (int ai = 0; ai < 2; ++ai)
#pragma unroll
            for (int m = 0; m < 4; ++m) {
                const float gt = gts[ai][m] * (1.f / (A_SCALE * W_SCALE));
                const u32x4 d0 = pack8(acc[ai][0][m][0] * gt, acc[ai][0][m][1] * gt), d1 = pack8(acc[ai][1][m][0] * gt, acc[ai][1][m][1] * gt);
                u32x4 rcv;
#pragma unroll
                for (int i = 0; i < 4; ++i) { const unsigned snd = lowr ? d1[i] : d0[i]; rcv[i] = (unsigned)__builtin_amdgcn_update_dpp(0, (int)snd, 0x128, 0xF, 0xF, true); }
                const size_t prow0 = (size_t)u.pm * CAP + ai * HALF + wr * 64 + m * 16;
                f16* c0 = y + u.pn * BM + wc * 64 + 8 * fq + 32 * hb;
                u32x4 s1, s2;
#pragma unroll
                for (int i = 0; i < 4; ++i) { s1[i] = lowr ? d0[i] : rcv[i]; s2[i] = lowr ? rcv[i] : d1[i]; }
                __builtin_nontemporal_store(s1, (u32x4*)(c0 + (prow0 + r8) * DM));
                __builtin_nontemporal_store(s2, (u32x4*)(c0 + (prow0 + 8 + r8) * DM));
            }
    }
};
}

namespace attn_body {
using s16x4 = __attribute__((ext_vector_type(4))) short;
using s16x8 = __attribute__((ext_vector_type(8))) short;
using f32x16 = __attribute__((ext_vector_type(16))) float;
constexpr int NW = 8, QBLK = 32, QB = QBLK * NW, KVBLK = 64, PITCH = INW;
constexpr int NSLOT = 3, SLOTB = 8192;
constexpr int LDS_K = 0, LDS_V = NSLOT * SLOTB, LDS_WS = 2 * NSLOT * SLOTB, LDS_OST = LDS_WS + NW * 64 * 4, LDS_BIAS = LDS_OST + NW * 4096, LDS_BYTES = LDS_BIAS + 640 * 4;
constexpr int BIAS_PAD = 64;
constexpr float NEGBIG = -1000.f;
DEVI int crow(int r, int hi) { return (r & 3) + 8 * (r >> 2) + 4 * hi; }
#define ASBAR() __builtin_amdgcn_sched_barrier(0)
DEVI void glds16s(const void* sbase, unsigned voff, unsigned lds_dst) { unsigned keep;
    asm volatile("s_mov_b32 %0, m0\n\ts_mov_b32 m0, %3\n\ts_nop 0\n\tglobal_load_lds_dwordx4 %1, %2\n\ts_mov_b32 m0, %0" : "=&s"(keep) : "v"(voff), "s"(sbase), "s"(lds_dst) : "memory"); }
DEVI float max3f(float a, float b, float c) { float r; asm("v_max3_f32 %0, %1, %2, %3" : "=v"(r) : "v"(a), "v"(b), "v"(c)); return r; }
DEVI float max2f(float a, float b) { float r; asm("v_max_f32_e32 %0, %1, %2" : "=v"(r) : "v"(a), "v"(b)); return r; }
DEVI float fadd_s(float a, float b) { float r; asm("v_add_f32_e32 %0, %1, %2" : "=v"(r) : "v"(a), "v"(b)); return r; }
DEVI float fsub_s(float a, float b) { float r; asm("v_sub_f32_e32 %0, %1, %2" : "=v"(r) : "v"(a), "v"(b)); return r; }
DEVI unsigned cvtpk_s(float lo, float hi) { return pk_h2(lo, hi); }
#define WAIT_BAR(N) asm volatile("s_waitcnt vmcnt(" #N ") lgkmcnt(0)\n\ts_barrier" ::: "memory")
#define MFMA32(a, b, c) __builtin_amdgcn_mfma_f32_32x32x16_f16(a, b, c, 0, 0, 0)
typedef LAS const char* lds_cptr;
typedef short v4i16_t __attribute__((ext_vector_type(4)));

DEVI void qkt(f32x16& p0, f32x16& p1, const char* Kslot, const f16x8* qr, const f32x16& negm, int r32, int hi) {
    const char* kb = Kslot + hi * 1024 + r32 * 16;
#pragma unroll
    for (int d0 = 0; d0 < 4; ++d0) {
        const f16x8 b0 = *reinterpret_cast<const f16x8*>(kb + d0 * 2048);
        const f16x8 b1 = *reinterpret_cast<const f16x8*>(kb + d0 * 2048 + 512);
        if (d0 == 0) { p0 = MFMA32(b0, qr[0], negm); p1 = MFMA32(b1, qr[0], negm); }
        else { p0 = MFMA32(b0, qr[d0], p0); p1 = MFMA32(b1, qr[d0], p1); } }
}
DEVI void kload8(f16x8* kf, lds_cptr kp) {
    kf[0] = *(const LAS f16x8*)(kp);        kf[1] = *(const LAS f16x8*)(kp + 512);
    kf[2] = *(const LAS f16x8*)(kp + 2048); kf[3] = *(const LAS f16x8*)(kp + 2560);
    kf[4] = *(const LAS f16x8*)(kp + 4096); kf[5] = *(const LAS f16x8*)(kp + 4608);
    kf[6] = *(const LAS f16x8*)(kp + 6144); kf[7] = *(const LAS f16x8*)(kp + 6656);
}
DEVI void kload2(f16x8* kf, lds_cptr kp, int j) { kf[2 * j] = *(const LAS f16x8*)(kp + j * 2048); kf[2 * j + 1] = *(const LAS f16x8*)(kp + j * 2048 + 512); }
DEVI s16x4 vtr(lds_cptr p) { return __builtin_bit_cast(s16x4, __builtin_amdgcn_ds_read_tr16_b64_v4i16((LAS v4i16_t*)p)); }
DEVI float rowmax(const f32x16& p0, const f32x16& p1) {
    float a = max3f(p0[0], p0[1], p1[0]), b = max3f(p0[2], p0[3], p1[1]); a = max3f(a, p1[2], p1[3]);
#pragma unroll
    for (int r = 4; r < 16; r += 4) { a = max3f(a, p0[r], p0[r + 1]); b = max3f(b, p0[r + 2], p0[r + 3]); a = max3f(a, p1[r], p1[r + 1]); b = max3f(b, p1[r + 2], p1[r + 3]); }
    const float m = max2f(a, b);
    auto rr = __builtin_amdgcn_permlane32_swap(__float_as_uint(m), __float_as_uint(m), false, false);
    return max2f(__uint_as_float(rr[0]), __uint_as_float(rr[1]));
}
DEVI void pv(f32x16* o, int vb, f16x8 pa0, f16x8 pa1, f16x8 pa2, f16x8 pa3) {
#pragma unroll
    for (int d0 = 0; d0 < 2; ++d0) { s16x4 lo[4], hi[4];
#pragma unroll
        for (int ks = 0; ks < 4; ++ks) {
            asm volatile("ds_read_b64_tr_b16 %0,%1 offset:%c2" : "=&v"(lo[ks]) : "v"(vb), "i"(d0 * 4096 + ks * 1024) : "memory");
            asm volatile("ds_read_b64_tr_b16 %0,%1 offset:%c2" : "=&v"(hi[ks]) : "v"(vb), "i"(d0 * 4096 + ks * 1024 + 512) : "memory"); }
        asm volatile("s_waitcnt lgkmcnt(0)" ::: "memory"); ASBAR();
#define PK(k) __builtin_bit_cast(f16x8, (s16x8){lo[k][0], lo[k][1], lo[k][2], lo[k][3], hi[k][0], hi[k][1], hi[k][2], hi[k][3]})
        o[d0] = MFMA32(pa0, PK(0), o[d0]);
        o[d0] = MFMA32(pa1, PK(1), o[d0]);
        o[d0] = MFMA32(pa2, PK(2), o[d0]);
        o[d0] = MFMA32(pa3, PK(3), o[d0]);
#undef PK
    }
}

struct AttnU {
    const f16* Qp;
    const f16* Kp;
    const f16* Vp;
    f16* Op;
    float* ssq;
    int NT;
    int r0, kr0;
    const float* rpb_h;
};

template <int THRL, int MODE> DEVI void attn_unit(const AttnU& U, const f16* nQ, const f16* nK, const f16* nV, const bool primed, f16x8 (&qr)[4], char* shm, const int wid) {
    const int lane = lane_id_v(), tid = wid * 64 + lane, r32 = lane & 31, hi = lane >> 5;
    const f16* Qw = U.Qp + (size_t)(wid * QBLK) * PITCH;
    const unsigned lds0 = (unsigned)(uintptr_t)shm;
    float* wsf = (float*)(shm + LDS_WS) + wid * 64;
    const unsigned koff = (unsigned)(lane * PITCH + wid * 8) * 2u;
    const unsigned voff = (unsigned)((16 * (wid & 3) + (lane >> 2)) * PITCH + (wid >> 2) * 32 + (lane & 3) * 8) * 2u;
    const unsigned kdst = lds0 + LDS_K + wid * 1024, vdst = lds0 + LDS_V + wid * 1024;
#define DMA_K(t, slot) glds16s(U.Kp + (size_t)(t) * KVBLK * PITCH, koff, (unsigned)__builtin_amdgcn_readfirstlane(kdst + (slot)))
#define DMA_V(t, slot) glds16s(U.Vp + (size_t)(t) * KVBLK * PITCH, voff, (unsigned)__builtin_amdgcn_readfirstlane(vdst + (slot)))
    const char* Kbase = shm + LDS_K; f16x8 kf[8];
    const lds_cptr shm3 = (lds_cptr)shm; const lds_cptr kp0 = shm3 + LDS_K + hi * 1024 + r32 * 16; const lds_cptr vp0 = shm3 + LDS_V + ((lane >> 4) & 1) * 32 + (lane & 3) * 8 + (4 * hi + ((lane & 15) >> 2)) * 64;
    const int NT = U.NT;
    if (!primed) {
        DMA_K(0, 0); DMA_V(0, 0); DMA_K(1, SLOTB);
#pragma unroll
        for (int d0 = 0; d0 < 4; ++d0) qr[d0] = *reinterpret_cast<const f16x8*>(&Qw[(size_t)r32 * PITCH + d0 * 16 + hi * 8]);
    }
    const LAS float* btab = (const LAS float*)(shm3 + LDS_BIAS);
    int na_lo = 0, na_lb0 = 0, na_rs = 0, na_qr = 0;
    if (MODE == 1) {
        LAS float* bw = (LAS float*)(shm3 + LDS_BIAS);
        for (int i = tid; i < 465; i += 512) bw[BIAS_PAD + i] = U.rpb_h[i] * LOG2E;
        na_qr = U.r0 + (wid >> 1); const int qc = 32 * (wid & 1) + r32;
        int cs = qc - 8; cs = cs < 0 ? 0 : (cs > GRIDW - 16 ? GRIDW - 16 : cs);
        na_rs = na_qr - 4; na_rs = na_rs < 0 ? 0 : (na_rs > GROWS - 8 ? GROWS - 8 : na_rs);
        na_lo = 4 * hi - cs;
        na_lb0 = BIAS_PAD + 15 - qc + 4 * hi;
    }
    float mhat = 0.f, l_reg = 0.f; f32x16 o[2]; o[0] = f32x16{}; o[1] = f32x16{}; f32x16 negm = f32x16{}; if (MODE == 0) asm volatile("" : "+v"(negm));
#define NEGM (MODE == 0 ? negm : f32x16{})
#define HOOK(P0, P1, t) do { if (MODE == 1) { const int kr_ = U.kr0 + (t); const bool rowok_ = (kr_ >= na_rs) && (kr_ < na_rs + 8); \
        if (rowok_) { const LAS float* bp_ = btab + ((kr_ - na_qr + 7) * 31 + na_lb0); const float nm_ = -mhat; \
            _Pragma("unroll") for (int r = 0; r < 16; ++r) { const int c0_ = (r & 3) + 8 * (r >> 2); \
                P0[r] = ((unsigned)(c0_ + na_lo) < 16u) ? (P0[r] + bp_[c0_]) + nm_ : NEGBIG; P1[r] = ((unsigned)(c0_ + 32 + na_lo) < 16u) ? (P1[r] + bp_[c0_ + 32]) + nm_ : NEGBIG; } } \
        else { _Pragma("unroll") for (int r = 0; r < 16; ++r) { P0[r] = NEGBIG; P1[r] = NEGBIG; } } } } while (0)
    bool resc = false;
#define START(P0, P1) do { const float rm = rowmax(P0, P1); resc = false; \
    { const float dl = rm; mhat = fadd_s(mhat, dl); \
      _Pragma("unroll") for (int r = 0; r < 16; ++r) { P0[r] = fsub_s(P0[r], dl); P1[r] = fsub_s(P1[r], dl); } \
      if (MODE == 0) { _Pragma("unroll") for (int r = 0; r < 16; ++r) negm[r] = -mhat; asm volatile("" : "+v"(negm)); } } \
    _Pragma("unroll") for (int r = 0; r < 16; ++r) P0[r] = __builtin_amdgcn_exp2f(P0[r]); } while (0)
#define RESC() do { if (resc) { asm volatile("s_waitcnt lgkmcnt(0)" ::: "memory"); \
      _Pragma("unroll") for (int d_ = 0; d_ < 2; ++d_) _Pragma("unroll") for (int r = 0; r < 16; ++r) o[d_][r] *= wsf[crow(r, hi)]; } } while (0)
    f32x16 pA0, pA1, pB0, pB1;
    int sl_prev = 0, sl_cur = 0, sl_next = SLOTB;
#define ROT() do { sl_prev = sl_cur; sl_cur = sl_next; sl_next = (sl_next == (NSLOT - 1) * SLOTB) ? 0 : sl_next + SLOTB; } while (0)
    DMA_K(2, 2 * SLOTB);
    WAIT_BAR(3);
    qkt(pA0, pA1, Kbase, qr, NEGM, r32, hi); asm volatile("s_nop 15\n\ts_nop 7" : "+v"(pA0), "+v"(pA1)); HOOK(pA0, pA1, 0);
    START(pA0, pA1);
#pragma unroll
    for (int r = 0; r < 16; ++r) pA1[r] = __builtin_amdgcn_exp2f(pA1[r]);
    WAIT_BAR(0);
    DMA_K(3, 0); DMA_V(1, SLOTB);
    ROT();
    kload8(kf, kp0 + sl_cur);
    WAIT_BAR(2);
    s16x4 vlo[8], vhi[8]; u32x4 pw0, pw1, pw2, pw3;
#define PKW(P, B) cvtpk_s(P[B], P[B + 1])
#define PAF(k) __builtin_bit_cast(f16x8, pw##k)
#define VFR(i) __builtin_bit_cast(f16x8, (s16x8){vlo[i][0], vlo[i][1], vlo[i][2], vlo[i][3], vhi[i][0], vhi[i][1], vhi[i][2], vhi[i][3]})
#define PIN(x) asm volatile("" : "+v"(x))
#define MX3(a, b, c) __builtin_fmaxf(__builtin_fmaxf((a), (b)), (c))
#define GAPA(MF, A0, A1, A2, A3, W0, W1, PW) do { MF; sacc += A0; sacc += A1; sacc += A2; sacc += A3; PIN(sacc); W0; W1; PIN(PW); ASBAR(); } while (0)
#define EX(v) __builtin_amdgcn_exp2f(v)
#define GAPB(MF, X, B) do { MF; X[B] = EX(X[B]); X[B + 1] = EX(X[B + 1]); X[B + 2] = EX(X[B + 2]); X[B + 3] = EX(X[B + 3]); PIN(X); ASBAR(); } while (0)
#define VRD(i) do { vlo[i] = vtr(vp_ + (((i) >> 2) * 4096 + ((i) & 3) * 1024)); vhi[i] = vtr(vp_ + (((i) >> 2) * 4096 + ((i) & 3) * 1024 + 512)); } while (0)
#define KRD(G, j) do { if (G) { kload2(kf, kp0 + sl_next, j); ASBAR(); } } while (0)
#define STEP(C0, C1, P0, P1, t, GK, GV, GL) do { ASBAR(); \
    const lds_cptr vp_ = vp0 + sl_prev; \
    VRD(0); ASBAR(); float sacc = (P0[0] + P0[1]); \
    GAPA(C0 = MFMA32(kf[0], qr[0], NEGM), P0[2], P0[3], P0[4], P0[5],     pw0[0] = PKW(P0, 0), pw0[1] = PKW(P0, 2), pw0); \
    VRD(4); ASBAR(); GAPA(C1 = MFMA32(kf[1], qr[0], NEGM), P0[6], P0[7], P0[8], P0[9],     pw0[2] = PKW(P0, 4), pw0[3] = PKW(P0, 6), pw0); \
    VRD(1); ASBAR(); GAPA(C0 = MFMA32(kf[2], qr[1], C0),   P0[10], P0[11], P0[12], P0[13], pw1[0] = PKW(P0, 8), pw1[1] = PKW(P0, 10), pw1); \
    VRD(5); ASBAR(); GAPA(C1 = MFMA32(kf[3], qr[1], C1),   P0[14], P0[15], P1[0], P1[1],   pw1[2] = PKW(P0, 12), pw1[3] = PKW(P0, 14), pw1); \
    VRD(2); ASBAR(); GAPA(C0 = MFMA32(kf[4], qr[2], C0),   P1[2], P1[3], P1[4], P1[5],     pw2[0] = PKW(P1, 0), pw2[1] = PKW(P1, 2), pw2); \
    VRD(6); ASBAR(); GAPA(C1 = MFMA32(kf[5], qr[2], C1),   P1[6], P1[7], P1[8], P1[9],     pw2[2] = PKW(P1, 4), pw2[3] = PKW(P1, 6), pw2); \
    VRD(3); ASBAR(); GAPA(C0 = MFMA32(kf[6], qr[3], C0),   P1[10], P1[11], P1[12], P1[13], pw3[0] = PKW(P1, 8), pw3[1] = PKW(P1, 10), pw3); \
    VRD(7); ASBAR(); GAPA(C1 = MFMA32(kf[7], qr[3], C1),   P1[14], P1[15], 0.f, 0.f,       pw3[2] = PKW(P1, 12), pw3[3] = PKW(P1, 14), pw3); \
    l_reg += sacc; \
    if (GK) { DMA_K((t) + 3, sl_cur); } if (GV) { DMA_V((t) + 1, sl_next); } \
    HOOK(C0, C1, t); \
    { float a = MX3(C0[0], C0[1], C1[0]), b = MX3(C0[2], C0[3], C1[1]); a = MX3(a, C1[2], C1[3]); \
      _Pragma("unroll") for (int r = 4; r < 16; r += 4) { a = MX3(a, C0[r], C0[r + 1]); b = MX3(b, C0[r + 2], C0[r + 3]); a = MX3(a, C1[r], C1[r + 1]); b = MX3(b, C1[r + 2], C1[r + 3]); } \
      float rm = __builtin_fmaxf(a, b); { auto rr = __builtin_amdgcn_permlane32_swap(__float_as_uint(rm), __float_as_uint(rm), false, false); rm = __builtin_fmaxf(__uint_as_float(rr[0]), __uint_as_float(rr[1])); } \
      resc = false; \
      if (__builtin_expect(__any(rm > (float)THRL), 0)) { const float dl = __builtin_fmaxf(rm, 0.f); mhat += dl; \
        _Pragma("unroll") for (int r = 0; r < 16; ++r) { C0[r] -= dl; C1[r] -= dl; } \
        if (MODE == 0) { _Pragma("unroll") for (int r = 0; r < 16; ++r) negm[r] = -mhat; asm volatile("" : "+v"(negm)); } \
        const float f = __builtin_amdgcn_exp2f(-dl); l_reg *= f; if (hi == 0) wsf[r32] = f; resc = true; } } \
    ASBAR(); \
    GAPB(o[0] = MFMA32(PAF(0), VFR(0), o[0]), C0, 0); \
    GAPB(o[1] = MFMA32(PAF(0), VFR(4), o[1]), C0, 4); \
    KRD(GL, 0); GAPB(o[0] = MFMA32(PAF(1), VFR(1), o[0]), C0, 8); \
    KRD(GL, 1); GAPB(o[1] = MFMA32(PAF(1), VFR(5), o[1]), C0, 12); \
    KRD(GL, 2); GAPB(o[0] = MFMA32(PAF(2), VFR(2), o[0]), C1, 0); \
    KRD(GL, 3); GAPB(o[1] = MFMA32(PAF(2), VFR(6), o[1]), C1, 4); \
    GAPB(o[0] = MFMA32(PAF(3), VFR(3), o[0]), C1, 8); \
    GAPB(o[1] = MFMA32(PAF(3), VFR(7), o[1]), C1, 12); \
    } while (0)
    int t = 1;
    for (; t + 5 < NT; t += 2) {
        STEP(pB0, pB1, pA0, pA1, t, true, true, true);       WAIT_BAR(2); RESC(); ROT();
        STEP(pA0, pA1, pB0, pB1, t + 1, true, true, true);   WAIT_BAR(2); RESC(); ROT();
    }
#define ENDW(tt) do { if ((tt) + 3 < NT) { WAIT_BAR(2); } else if ((tt) + 2 < NT) { WAIT_BAR(1); } else { WAIT_BAR(0); } } while (0)
    for (; t + 1 < NT; t += 2) {
        STEP(pB0, pB1, pA0, pA1, t, (t + 3 < NT), (t + 1 < NT), (t + 1 < NT));         ENDW(t);     RESC(); ROT();
        STEP(pA0, pA1, pB0, pB1, t + 1, (t + 4 < NT), (t + 2 < NT), (t + 2 < NT));     ENDW(t + 1); RESC(); ROT();
    }
    STEP(pB0, pB1, pA0, pA1, NT - 1, false, false, false); RESC();
    { float sacc = pB0[0] + pB0[1];
#pragma unroll
      for (int r = 2; r < 16; ++r) sacc += pB0[r];
#pragma unroll
      for (int r = 0; r < 16; ++r) sacc += pB1[r];
      l_reg += sacc;
      pw0 = (u32x4){PKW(pB0, 0), PKW(pB0, 2), PKW(pB0, 4), PKW(pB0, 6)}; pw1 = (u32x4){PKW(pB0, 8), PKW(pB0, 10), PKW(pB0, 12), PKW(pB0, 14)}; pw2 = (u32x4){PKW(pB1, 0), PKW(pB1, 2), PKW(pB1, 4), PKW(pB1, 6)}; pw3 = (u32x4){PKW(pB1, 8), PKW(pB1, 10), PKW(pB1, 12), PKW(pB1, 14)};
      ASBAR(); pv(o, (int)(unsigned)(__SIZE_TYPE__)(vp0 + sl_cur), PAF(0), PAF(1), PAF(2), PAF(3)); }
    if (nK) {
        asm volatile("s_waitcnt lgkmcnt(0)\n\ts_barrier" ::: "memory");
        glds16s(nK, koff, (unsigned)__builtin_amdgcn_readfirstlane(kdst)); glds16s(nV, voff, (unsigned)__builtin_amdgcn_readfirstlane(vdst)); glds16s(nK + (size_t)KVBLK * PITCH, koff, (unsigned)__builtin_amdgcn_readfirstlane(kdst + SLOTB));
        const f16* nQw = nQ + (size_t)(wid * QBLK) * PITCH;
#pragma unroll
        for (int d0 = 0; d0 < 4; ++d0) qr[d0] = *reinterpret_cast<const f16x8*>(&nQw[(size_t)r32 * PITCH + d0 * 16 + hi * 8]);
    }
#undef PKW
#undef PAF
#undef VFR
#undef PIN
#undef MX3
#undef GAPA
#undef GAPB
#undef EX
#undef VRD
#undef KRD
#undef STEP
#undef ENDW
    { auto rr = __builtin_amdgcn_permlane32_swap(__float_as_uint(l_reg), __float_as_uint(l_reg), false, false); l_reg = __uint_as_float(rr[0]) + __uint_as_float(rr[1]); }
    if (hi == 0) wsf[32 + r32] = l_reg; asm volatile("s_waitcnt lgkmcnt(0)" ::: "memory");
    float rli[16];
#pragma unroll
    for (int r = 0; r < 16; ++r) rli[r] = __builtin_amdgcn_rcpf(wsf[32 + crow(r, hi)]);
    f16* Ow = U.Op + (size_t)(wid * QBLK) * MIXW;
    { f16* stg = (f16*)(shm + LDS_OST) + wid * 2048;
#pragma unroll
      for (int r = 0; r < 16; ++r) { const int orow = crow(r, hi);
#pragma unroll
        for (int d0 = 0; d0 < 2; ++d0) stg[orow * 64 + d0 * 32 + r32] = (f16)(o[d0][r] * rli[r]); }
      asm volatile("s_waitcnt lgkmcnt(0)" ::: "memory");
#pragma unroll
      for (int i = 0; i < 4; ++i) { const int row = i * 8 + (lane >> 3), ch = lane & 7; const u32x4 v = *(const u32x4*)(stg + row * 64 + ch * 8); *(u32x4*)(Ow + (size_t)row * MIXW + ch * 8) = v;
        float f[8]; h8_to_f(v, f); float s = 0.f;
#pragma unroll
        for (int j = 0; j < 8; ++j) s += f[j] * f[j];
        s += __shfl_xor(s, 1); s += __shfl_xor(s, 2); s += __shfl_xor(s, 4);
        if (ch == 0) U.ssq[wid * QBLK + row] = s; } }
    if (!nK) asm volatile("s_waitcnt lgkmcnt(0)\n\ts_barrier" ::: "memory");
#undef DMA_K
#undef DMA_V
#undef NEGM
#undef HOOK
#undef START
#undef RESC
#undef ROT
}
#undef ASBAR
#undef WAIT_BAR
#undef MFMA32
}

constexpr int NWAVES = 8, NPHASE = 9;
constexpr int RING_BYTES = 131072, LDS_TOTAL = 163840;
constexpr int LDS_IDX16 = RING_BYTES + 64, LDS_RSS = LDS_IDX16 + 16 * CAP * 2;
enum { PH_PRO = 0, PH_QKV = 1, PH_ATT = 2, PH_OUT = 3, PH_ROUTER = 4, PH_TOPK = 5, PH_E1 = 6, PH_E2 = 7, PH_COMB = 8 };
struct MArgs { const float* in[16]; float* out; unsigned char* ws; int ph_lo, ph_hi; };

template <bool FP8, class RowMap, class KScale>
DEVI void p0_transpose_item(const float* __restrict__ W, int K, int N, void* __restrict__ WTv, LAS float* scr, int item, int lane, const RowMap& rm, const KScale& ks) {
    const int nblk = N / 32, kb = item / nblk, nb = item - kb * nblk, k0 = 64 * kb, n0 = 32 * nb;
#pragma unroll 8
    for (int i = 0; i < 32; ++i) { const int kk = 2 * i + (lane >> 5); scr[kk * 33 + (lane & 31)] = __builtin_nontemporal_load(W + (size_t)(k0 + kk) * N + n0 + (lane & 31)); }
    WAIT_L(0); asm volatile("" ::: "memory");
    const int c = lane & 7;
    float kv[8];
#pragma unroll
    for (int q = 0; q < 8; ++q) kv[q] = ks(k0 + 8 * c + q);
#pragma unroll
    for (int j = 0; j < 4; ++j) { const int n = (lane >> 3) + 8 * j; const LAS float* s = scr + (8 * c) * 33 + n;
        if constexpr (FP8) { u32x2 o; o.x = pk_f8x4(s[0 * 33] * kv[0], s[1 * 33] * kv[1], s[2 * 33] * kv[2], s[3 * 33] * kv[3]); o.y = pk_f8x4(s[4 * 33] * kv[4], s[5 * 33] * kv[5], s[6 * 33] * kv[6], s[7 * 33] * kv[7]);
            const int r_ = rm(n0 + n), kk_ = k0 + 8 * c;
            *(u32x2*)((unsigned char*)WTv + ((size_t)(r_ >> 8) * (K >> 7) + (kk_ >> 7)) * 32768 + (size_t)(r_ & 255) * 128 + (kk_ & 127)) = o; }
        else { u32x4 o; o.x = pk_h2(s[0 * 33] * kv[0], s[1 * 33] * kv[1]); o.y = pk_h2(s[2 * 33] * kv[2], s[3 * 33] * kv[3]); o.z = pk_h2(s[4 * 33] * kv[4], s[5 * 33] * kv[5]); o.w = pk_h2(s[6 * 33] * kv[6], s[7 * 33] * kv[7]);
            *(u32x4*)((f16*)WTv + (size_t)rm(n0 + n) * K + k0 + 8 * c) = o; } }
    WAIT_L(0); asm volatile("" ::: "memory");
}
struct RmSigma { DEVI int operator()(int n) const { return (n & ~255) + pg8::sigma_inv(n & 255); } };
struct RmGU { int up; DEVI int operator()(int f) const { const int pn = f >> 7, fl = f & 127; return 256 * pn + 128 * up + 32 * (fl >> 5) + 16 * ((fl >> 2) & 1) + 4 * ((fl >> 3) & 3) + (fl & 3); } };
struct KsOne { DEVI float operator()(int) const { return 1.f; } };
struct KsVec { const float* g; float sc; DEVI float operator()(int k) const { return g[k] * sc; } };
struct KsConst { float sc; DEVI float operator()(int) const { return sc; } };
struct KsOutG { const float *ga, *gb; DEVI float operator()(int k) const { return k < 512 ? ga[k] : gb[k - 512]; } };

DEVI void rmsnorm1_row(const float* __restrict__ xrow, float* __restrict__ rms_out, f16* __restrict__ orow, int lane) {
    const f32x4* xr = (const f32x4*)xrow + lane;
    f32x4 v[4]; float s = 0.f;
#pragma unroll
    for (int j = 0; j < 4; ++j) { v[j] = __builtin_nontemporal_load(xr + 64 * j); s += (v[j].x * v[j].x + v[j].y * v[j].y) + (v[j].z * v[j].z + v[j].w * v[j].w); }
    const float rstd = rsqrtf(wave_sum(s) * (1.f / DM) + EPS);
    if (lane == 0) *rms_out = 1.f / rstd;
    u32x2* o = (u32x2*)orow + lane;
#pragma unroll
    for (int j = 0; j < 4; ++j) { u32x2 w; w.x = pk_h2(v[j].x * rstd, v[j].y * rstd); w.y = pk_h2(v[j].z * rstd, v[j].w * rstd); o[64 * j] = w; }
}

DEVI void router_phase(LAS unsigned char* lds, const float* __restrict__ h, const float* __restrict__ g2, const float* __restrict__ wr, float* __restrict__ aff, float* __restrict__ rstd2, int bid, int G, const int wave) {
    LAS f32x4* wr4 = (LAS f32x4*)lds;
    const int lane = lane_id_v(), tid = wave * 64 + lane;
    for (int i = tid; i < DM * 4; i += 512) { const int k = i >> 2, c4 = i & 3; const f32x4 w = ((const f32x4*)wr)[i] * g2[k]; wr4[k * 4 + (c4 ^ ((k >> 2) & 3))] = w; }
    __syncthreads();
    const int sw = (lane >> 2) & 3;
#define RT_LOAD(dst, t_) do { const float* hp_ = h + (size_t)(t_) * DM + lane; _Pragma("unroll") for (int i = 0; i < 16; ++i) dst[i] = hp_[64 * i]; } while (0)
#define RT_ROW(src, t_) do { float ssq = 0.f; float lg[16]; \
        _Pragma("unroll") for (int e = 0; e < 16; ++e) lg[e] = 0.f; \
        _Pragma("unroll") for (int i = 0; i < 16; ++i) { const int k = lane + 64 * i; const float hv = src[i]; ssq += hv * hv; \
            _Pragma("unroll") for (int c4 = 0; c4 < 4; ++c4) { const f32x4 w = wr4[k * 4 + (c4 ^ sw)]; lg[4 * c4 + 0] += hv * w.x; lg[4 * c4 + 1] += hv * w.y; lg[4 * c4 + 2] += hv * w.z; lg[4 * c4 + 3] += hv * w.w; } if ((i & 1) == 1) SCHED0; } \
        const float rs = rsqrtf(wave_sum(ssq) * (1.f / DM) + EPS); float mx = -1e30f; \
        _Pragma("unroll") for (int e = 0; e < 16; ++e) { lg[e] = wave_sum(lg[e]) * rs; mx = fmaxf(mx, lg[e]); } \
        float sum = 0.f; \
        _Pragma("unroll") for (int e = 0; e < 16; ++e) { lg[e] = __expf(lg[e] - mx); sum += lg[e]; } \
        float mine = 0.f; \
        _Pragma("unroll") for (int e = 0; e < 16; ++e) mine = (lane == e) ? lg[e] : mine; \
        const int b_ = (t_) >> 11, tt_ = (t_) & (SEQ - 1); \
        if (lane < 16) aff[((size_t)b_ * NEXP + lane) * SEQ + tt_] = mine / sum; \
        if (lane == 0) rstd2[t_] = rs; } while (0)
    for (int item = bid; item < MTOK / 128; item += G) {
        const int t0 = item * 128 + wave * 16;
        float ha[16], hb[16];
        RT_LOAD(ha, t0);
        for (int r = 0; r < 16; r += 2) {
            RT_LOAD(hb, t0 + r + 1);
            RT_ROW(ha, t0 + r);
            if (r + 2 < 16) RT_LOAD(ha, t0 + r + 2);
            RT_ROW(hb, t0 + r + 1);
        }
    }
#undef RT_LOAD
#undef RT_ROW
    __syncthreads();
}
DEVI int lds_block_sum512(int v, LAS int* red, int tid) {
    const int lane = tid & 63, wave = tid >> 6;
#pragma unroll
    for (int o = 1; o < 64; o <<= 1) v += __shfl_xor(v, o);
    if (lane == 0) red[wave] = v;
    __syncthreads();
    int s = 0;
#pragma unroll
    for (int w = 0; w < 8; ++w) s += red[w];
    return s;
}
DEVI int lds_block_excl_scan512(int v, LAS int* red, int tid) {
    const int lane = tid & 63, wave = tid >> 6;
    int inc = v;
#pragma unroll
    for (int o = 1; o < 64; o <<= 1) { const int n = __shfl_up(inc, o); if (lane >= o) inc += n; }
    if (lane == 63) red[wave] = inc;
    __syncthreads();
    int base = 0;
#pragma unroll
    for (int w = 0; w < 8; ++w) base += (w < wave) ? red[w] : 0;
    return base + inc - v;
}
DEVI void topk_phase(LAS unsigned char* lds, const float* __restrict__ aff, const float* __restrict__ rstd2, int* __restrict__ idx, float* __restrict__ rss, float* __restrict__ gate, short* __restrict__ inv, int bid, int G, const int wave) {
    LAS int* red = (LAS int*)lds;
    const int tid = wave * 64 + lane_id_v();
    for (int be = bid; be < NB * NEXP; be += G) {
        const int b = be >> 4, e = be & 15;
        const f32x4 a4 = ((const f32x4*)(aff + (size_t)be * SEQ))[tid];
        const float av[4] = {a4.x, a4.y, a4.z, a4.w};
        unsigned bits[4];
#pragma unroll
        for (int j = 0; j < 4; ++j) bits[j] = __float_as_uint(av[j]);
        unsigned lo = 0u, hi = 0x7f800000u; int it = 0;
        while (lo < hi) {
            const unsigned mid = lo + ((hi - lo + 1u) >> 1);
            int c = 0;
#pragma unroll
            for (int j = 0; j < 4; ++j) c += (bits[j] >= mid) ? 1 : 0;
            const int tot = lds_block_sum512(c, red + 8 * (it & 1), tid);
            if (tot >= CAP) lo = mid; else hi = mid - 1u;
            ++it;
        }
        const unsigned theta = lo;
        int cgt = 0, ceq = 0;
#pragma unroll
        for (int j = 0; j < 4; ++j) { cgt += (bits[j] > theta) ? 1 : 0; ceq += (bits[j] == theta) ? 1 : 0; }
        const int ngt = lds_block_sum512(cgt, red + 16, tid);
        const int need = CAP - ngt;
        int eqr = lds_block_excl_scan512(ceq, red + 24, tid);
        int sel[4]; int csel = 0;
#pragma unroll
        for (int j = 0; j < 4; ++j) { const bool eq = bits[j] == theta; sel[j] = (bits[j] > theta || (eq && eqr < need)) ? 1 : 0; eqr += eq ? 1 : 0; csel += sel[j]; }
        __syncthreads();
        int slot = lds_block_excl_scan512(csel, red, tid);
#pragma unroll
        for (int j = 0; j < 4; ++j) {
            const int t = 4 * tid + j; short s = -1;
            if (sel[j]) { s = (short)slot; idx[be * CAP + slot] = t; gate[be * CAP + slot] = av[j]; rss[be * CAP + slot] = rstd2[b * SEQ + t]; ++slot; }
            inv[(size_t)be * SEQ + t] = s;
        }
        __syncthreads();
    }
}
DEVI int wave_isum(int v) {
#pragma unroll
    for (int o = 1; o < 64; o <<= 1) v += __shfl_xor(v, o);
    return v;
}
DEVI int wave_excl_scan(int v, int lane) {
    int inc = v;
#pragma unroll
    for (int o = 1; o < 64; o <<= 1) { const int n = __shfl_up(inc, o); if (lane >= o) inc += n; }
    return inc - v;
}
DEVI void topk_wave(const float* __restrict__ aff, const float* __restrict__ rstd2, int* __restrict__ idx, float* __restrict__ rss, float* __restrict__ gate, short* __restrict__ inv, int be, int lane) {
    const int b = be >> 4;
    const f32x4* ap = (const f32x4*)(aff + (size_t)be * SEQ + 32 * lane);
    unsigned bits[32];
#pragma unroll
    for (int q = 0; q < 8; ++q) { const f32x4 a = ap[q]; bits[4 * q] = __float_as_uint(a.x); bits[4 * q + 1] = __float_as_uint(a.y); bits[4 * q + 2] = __float_as_uint(a.z); bits[4 * q + 3] = __float_as_uint(a.w); }
    unsigned lo = 0u, hi = 0x7f800000u;
    while (lo < hi) {
        const unsigned mid = lo + ((hi - lo + 1u) >> 1);
        int c = 0;
#pragma unroll
        for (int j = 0; j < 32; ++j) c += (bits[j] >= mid) ? 1 : 0;
        const int tot = __builtin_amdgcn_readfirstlane(wave_isum(c));
        if (tot >= CAP) lo = mid; else hi = mid - 1u;
    }
    const unsigned theta = lo;
    int cgt = 0, ceq = 0;
#pragma unroll
    for (int j = 0; j < 32; ++j) { cgt += (bits[j] > theta) ? 1 : 0; ceq += (bits[j] == theta) ? 1 : 0; }
    const int need = CAP - wave_isum(cgt);
    int eqr = wave_excl_scan(ceq, lane);
    unsigned selm = 0u; int csel = 0;
#pragma unroll
    for (int j = 0; j < 32; ++j) { const bool eq = bits[j] == theta; const bool sl = (bits[j] > theta) || (eq && eqr < need); eqr += eq ? 1 : 0; selm |= sl ? (1u << j) : 0u; csel += sl ? 1 : 0; }
    int slot = wave_excl_scan(csel, lane);
    const f32x4* rp = (const f32x4*)(rstd2 + (size_t)b * SEQ + 32 * lane);
    u32x4* ip = (u32x4*)(inv + (size_t)be * SEQ + 32 * lane);
#pragma unroll
    for (int q = 0; q < 4; ++q) {
        unsigned w[4];
#pragma unroll
        for (int h = 0; h < 2; ++h) { const f32x4 rs = rp[2 * q + h];
#pragma unroll
            for (int i = 0; i < 4; ++i) { const int j = 8 * q + 4 * h + i; unsigned s16 = 0xFFFFu;
                if ((selm >> j) & 1u) { s16 = (unsigned)slot; idx[be * CAP + slot] = 32 * lane + j; gate[be * CAP + slot] = __uint_as_float(bits[j]); rss[be * CAP + slot] = rs[i]; ++slot; }
                if (i & 1) w[2 * h + (i >> 1)] |= s16 << 16; else w[2 * h + (i >> 1)] = s16; } }
        u32x4 o; o.x = w[0]; o.y = w[1]; o.z = w[2]; o.w = w[3]; ip[q] = o;
    }
}
DEVI void combine_acc(f32x4 (&v)[4], const f16* __restrict__ y, const short* __restrict__ invt, int row, int lane) {
    const int b = row >> 11, tt = row & (SEQ - 1);
    int sl[NEXP];
#pragma unroll
    for (int e = 0; e < NEXP; ++e) { const unsigned idx = (unsigned)((b * NEXP + e) * SEQ + tt); const unsigned w = ((const unsigned*)invt)[idx >> 1]; sl[e] = (int)(short)(w >> (16 * (idx & 1))); }
#pragma unroll
    for (int e = 0; e < NEXP; ++e) {
        const int s = sl[e];
        if (s >= 0) {
            const u32x2* yr = (const u32x2*)(y + ((size_t)(b * NEXP + e) * CAP + s) * DM) + lane;
#pragma unroll
            for (int j = 0; j < 4; ++j) { const f16x4 hh = __builtin_bit_cast(f16x4, yr[64 * j]); v[j].x += (float)hh[0]; v[j].y += (float)hh[1]; v[j].z += (float)hh[2]; v[j].w += (float)hh[3]; }
        }
    }
}
DEVI void combine_rows2(float* __restrict__ out, const f16* __restrict__ h16, const f16* __restrict__ y, const short* __restrict__ inv, int row0, int row1, int lane) {
    const u32x2* h0 = (const u32x2*)(h16 + (size_t)row0 * DM) + lane; const u32x2* h1 = (const u32x2*)(h16 + (size_t)row1 * DM) + lane;
    f32x4 v0[4], v1[4];
#pragma unroll
    for (int j = 0; j < 4; ++j) { const f16x4 p = __builtin_bit_cast(f16x4, h0[64 * j]), q = __builtin_bit_cast(f16x4, h1[64 * j]);
        v0[j] = (f32x4){(float)p[0], (float)p[1], (float)p[2], (float)p[3]}; v1[j] = (f32x4){(float)q[0], (float)q[1], (float)q[2], (float)q[3]}; }
    combine_acc(v0, y, inv, row0, lane);
    combine_acc(v1, y, inv, row1, lane);
    f32x4* o0 = (f32x4*)(out + (size_t)row0 * DM) + lane; f32x4* o1 = (f32x4*)(out + (size_t)row1 * DM) + lane;
#pragma unroll
    for (int j = 0; j < 4; ++j) { o0[64 * j] = v0[j]; o1[64 * j] = v1[j]; }
}

#define XB_TMO      128
#define XB_XCNT(j)  (256  + 64 * (j))
#define XB_XSUB(j)  (1280 + 64 * (j))
#define XB_XGEN(j)  (2304 + 64 * (j))
#define XB_TOP      3328
#define XB_TOPGEN   3392
#define XCD_BAR_WORDS 3456
#define XB_SPIN_CAP (1u << 22)
DEVI unsigned xb_ld(unsigned* p)              { return __hip_atomic_load(p, __ATOMIC_RELAXED, __HIP_MEMORY_SCOPE_AGENT); }
DEVI unsigned xb_add(unsigned* p, unsigned v) { return __hip_atomic_fetch_add(p, v, __ATOMIC_RELAXED, __HIP_MEMORY_SCOPE_AGENT); }
DEVI unsigned xb_xcc_id() { return (unsigned)__builtin_amdgcn_s_getreg((3 << 11) | 20) & 0xFu; }
#define XB_SPIN(cond, bar) do { unsigned _sp = 0; while (cond) { __builtin_amdgcn_s_sleep(1); \
    if ((++_sp & 255u) == 0u) { if (xb_ld(&(bar)[XB_TMO])) break; if (_sp > XB_SPIN_CAP) { atomicAdd(&(bar)[XB_TMO], 1u); break; } } } } while (0)
struct XcdBarrier { unsigned* bar; unsigned x; volatile LAS unsigned* st; };
DEVI XcdBarrier xcd_barrier_post(unsigned* bar, volatile LAS unsigned* st, bool leader) {
    XcdBarrier b; b.bar = bar; b.x = xb_xcc_id(); b.st = st;
    if (leader) (void)xb_add(&bar[XB_XCNT(b.x)], 1u);
    return b;
}
DEVI void xcd_barrier_complete(unsigned* bar, unsigned x, unsigned& nloc, unsigned& nx) {
    const unsigned G = gridDim.x;
    unsigned sum, cnt, mine, sp = 0u;
    for (;;) {
        sum = 0u; cnt = 0u; mine = 0u;
#pragma unroll
        for (unsigned j = 0; j < 16; ++j) { const unsigned c = xb_ld(&bar[XB_XCNT(j)]); sum += c; cnt += (c > 0u) ? 1u : 0u; mine = (j == x) ? c : mine; }
        if (sum == G) break;
        __builtin_amdgcn_s_sleep(1);
        if ((++sp & 255u) == 0u) { if (xb_ld(&bar[XB_TMO])) break; if (sp > XB_SPIN_CAP) { atomicAdd(&bar[XB_TMO], 1u); break; } }
    }
    nloc = mine > 0u ? mine : 1u; nx = cnt > 0u ? cnt : 1u;
}
DEVI void xcd_barrier_leader(const XcdBarrier& b) {
    {
        unsigned* bar = b.bar;
        __builtin_amdgcn_s_waitcnt(0);
        unsigned nloc = b.st[0], nx = b.st[1];
        if (nloc == 0u) { xcd_barrier_complete(bar, b.x, nloc, nx); b.st[0] = nloc; b.st[1] = nx; }
        const unsigned old = xb_add(&bar[XB_XSUB(b.x)], 1u);
        const unsigned gen = old / nloc;
        if (old + 1u == (gen + 1u) * nloc) {
            __builtin_amdgcn_fence(__ATOMIC_RELEASE, "agent");
            asm volatile("s_waitcnt vmcnt(0)" ::: "memory");
            const unsigned og = xb_add(&bar[XB_TOP], 1u);
            const unsigned tg = og / nx;
            if (og + 1u == (tg + 1u) * nx) xb_add(&bar[XB_TOPGEN], 1u);
            else XB_SPIN(xb_ld(&bar[XB_TOPGEN]) == tg, bar);
            __builtin_amdgcn_fence(__ATOMIC_ACQUIRE, "agent");
            xb_add(&bar[XB_XGEN(b.x)], 1u);
            asm volatile("s_waitcnt vmcnt(0)" ::: "memory");
        } else {
            XB_SPIN(xb_ld(&bar[XB_XGEN(b.x)]) == gen, bar);
            __builtin_amdgcn_fence(__ATOMIC_ACQUIRE, "agent");
            asm volatile("s_waitcnt vmcnt(0)" ::: "memory");
        }
    }
}
DEVI void xcd_barrier(const XcdBarrier& b, bool leader) {
    asm volatile("s_waitcnt vmcnt(0)" ::: "memory");
    __syncthreads();
    if (leader) xcd_barrier_leader(b);
    __syncthreads();
}

__device__ unsigned g_ctl[CTL_ZERO_BYTES / 4];
constexpr int CTL_EXIT = 16000;
static_assert(CTL_EXIT * 4 >= 57344 + 8 * 256 && CTL_EXIT * 4 + 4 <= (int)CTL_ZERO_BYTES, "exit counter must not overlap the queue heads");
__global__ void __launch_bounds__(NWAVES * 64, 2) mega_fwd(MArgs args) {
    __builtin_assume(__builtin_amdgcn_workitem_id_y() == 0); __builtin_assume(__builtin_amdgcn_workitem_id_z() == 0);
    extern __shared__ __attribute__((aligned(16))) unsigned char lds_raw[];
    LAS unsigned char* lds = (LAS unsigned char*)lds_raw;
    const int wave = __builtin_amdgcn_readfirstlane((int)threadIdx.x >> 6);
    const int G = gridDim.x, bx = blockIdx.x, vcu = (G % 8 == 0) ? (bx % 8) * (G / 8) + bx / 8 : bx;
    const float* x = args.in[0]; const float* norm1_g = args.in[1]; const float* w_in = args.in[2];
    const float* g_naq = args.in[3]; const float* g_nak = args.in[4]; const float* rpb = args.in[5];
    const float* g_gq = args.in[6]; const float* g_gk = args.in[7]; const float* g_oa = args.in[8]; const float* g_ob = args.in[9];
    const float* w_out = args.in[10]; const float* norm2_g = args.in[11]; const float* w_router = args.in[12];
    const float* w_gate = args.in[13]; const float* w_up = args.in[14]; const float* w_down = args.in[15];
    float* out = args.out; unsigned char* ws = args.ws;
    f16* XN = (f16*)(ws + WS_XN); f16* H16 = (f16*)(ws + WS_H16); f16* PROJ = (f16*)(ws + WS_PROJ); f16* ATT = (f16*)(ws + WS_ATT); unsigned char* ACT = ws + WS_ACT; f16* Y = (f16*)(ws + WS_Y); unsigned char* H8 = ws + WS_H8;
    f16* WinT = (f16*)(ws + WS_WINT); f16* WoT = (f16*)(ws + WS_WOT); unsigned char* W1T = ws + WS_W1T; unsigned char* W2T = ws + WS_W2T;
    float* SSQP = (float*)(ws + WS_SSQP); float* AFF = (float*)(ws + WS_AFF); float* RSTD2 = (float*)(ws + WS_RSTD2);
    int* IDX = (int*)(ws + WS_IDX); float* RSS = (float*)(ws + WS_RSS); float* GATE = (float*)(ws + WS_GATE); short* INV = (short*)(ws + WS_INV);
    const int lo = args.ph_lo, hi = args.ph_hi;
#ifndef PH_BUILD
#define PH_BUILD 0x1FF
#endif
#define IN(k) (((PH_BUILD >> (k)) & 1) && lo <= (k) && (k) < hi)
#ifndef REPEAT_PH
#define REPEAT_PH -1
#endif
#ifndef REPEAT_N
#define REPEAT_N 2
#endif
#define REPS(k) for (int rep_ = 0; rep_ < ((REPEAT_PH == (k)) ? REPEAT_N : 1); ++rep_)
#define REPBAR() do { if (rep_ > 0) xcd_barrier(gbar, (wave == 0) && (lane_id_v() == 0)); } while (0)
    volatile LAS unsigned* MISC = (volatile LAS unsigned*)(lds + RING_BYTES);
    const bool leader = (wave == 0) && (lane_id_v() == 0);
    if (leader) { MISC[0] = 0u; MISC[1] = 0u; }
    if (lane_id_v() == 0) MISC[8 + wave] = 0u;
    __syncthreads();
    unsigned char* const ctl = (unsigned char*)g_ctl;
    XcdBarrier gbar; gbar.bar = (unsigned*)ctl; gbar.x = 0; gbar.st = MISC;
    if (hi - lo > 1 || REPEAT_PH >= 0) gbar = xcd_barrier_post((unsigned*)ctl, MISC, leader);
#define SEAM(k) do { if (IN(k) && IN((k) + 1)) { xcd_barrier(gbar, (wave == 0) && (lane_id_v() == 0)); } } while (0)
    constexpr int CV_I_GU = (DM / 64) * (DEXP / 32), CV_I_DN = (DEXP / 64) * (DM / 32), CV_N_IT = NEXP * (2 * CV_I_GU + CV_I_DN);
#define CONV_ITEM(it_, scr_, lane_) do { const int e_ = (it_) / (2 * CV_I_GU + CV_I_DN); int r_ = (it_) - e_ * (2 * CV_I_GU + CV_I_DN); \
        if (r_ < CV_I_GU) p0_transpose_item<true>(w_gate + (size_t)e_ * DM * DEXP, DM, DEXP, W1T + (size_t)e_ * 5632 * DM, scr_, r_, lane_, RmGU{0}, KsVec{norm2_g, W_SCALE}); \
        else if (r_ < 2 * CV_I_GU) p0_transpose_item<true>(w_up + (size_t)e_ * DM * DEXP, DM, DEXP, W1T + (size_t)e_ * 5632 * DM, scr_, r_ - CV_I_GU, lane_, RmGU{1}, KsVec{norm2_g, W_SCALE}); \
        else p0_transpose_item<true>(w_down + (size_t)e_ * DEXP * DM, DEXP, DM, W2T + (size_t)e_ * DM * DEXP, scr_, r_ - 2 * CV_I_GU, lane_, RmSigma{}, KsConst{W_SCALE}); } while (0)
    constexpr int CV_POOL = CV_N_IT / 8;
    static_assert(CV_N_IT % 8 == 0, "pools");
    const int cvpool = bx & 7;
    unsigned* cvhead = (unsigned*)(ctl + 57344) + 64 * cvpool;
#define CV_DEQ() ((lane_id_v() == 0) ? __hip_atomic_fetch_add(cvhead, 1u, __ATOMIC_RELAXED, __HIP_MEMORY_SCOPE_AGENT) : 0u)
#define CV_SESSION(STOPPABLE) do { const int lane_ = lane_id_v(); LAS float* scr_ = (LAS float*)(lds + 4096 + wave * 16384); \
        unsigned cur_ = MISC[8 + wave]; \
        if (cur_ == 0u) cur_ = (unsigned)__builtin_amdgcn_readfirstlane(CV_DEQ()) + 1u; \
        for (;;) { \
            if (cur_ - 1u >= (unsigned)CV_POOL) { cur_ = (unsigned)CV_POOL + 1u; break; }        \
            const unsigned pend_ = CV_DEQ(); \
            CONV_ITEM((int)(cur_ - 1u) * 8 + cvpool, scr_, lane_); \
            cur_ = (unsigned)__builtin_amdgcn_readfirstlane(pend_) + 1u; \
            if ((STOPPABLE) && MISC[5] != 0u) break; } \
        MISC[8 + wave] = cur_; } while (0)
#define SEAM_CV(k) do { if (IN(k) && IN((k) + 1)) { \
        asm volatile("s_waitcnt vmcnt(0)" ::: "memory"); \
        if (leader) MISC[5] = 0u; \
        __syncthreads(); \
        if (wave == 0) { if (leader) { xcd_barrier_leader(gbar); MISC[5] = 1u; } } \
        else { if (MISC[8 + wave] != (unsigned)CV_POOL + 1u) CV_SESSION(true); } \
        __syncthreads(); } } while (0)

    if (IN(PH_PRO)) REPS(PH_PRO) {
        REPBAR();
        const int lane = lane_id_v();
        LAS float* scr = (LAS float*)(lds + wave * 16384);
        const int gw = vcu * NWAVES + wave, NGW = G * NWAVES;
        constexpr int I_IN = (DM / 64) * (INW / 32), I_OUT = (DM / 64) * (DM / 32), I_GU = (DM / 64) * (DEXP / 32), I_DN = (DEXP / 64) * (DM / 32);
        for (int it = gw; it < I_IN + I_OUT; it += NGW) {
            int r = it;
            if (r < I_IN) { p0_transpose_item<false>(w_in, DM, INW, WinT, scr, r, lane, RmSigma{}, KsVec{norm1_g, 1.f}); continue; } r -= I_IN;
            p0_transpose_item<false>(w_out, MIXW, DM, WoT, scr, r, lane, RmSigma{}, KsOutG{g_oa, g_ob});
        }
        for (int m = gw; m < MTOK; m += NGW) rmsnorm1_row(x + (size_t)m * DM, (float*)(ws + WS_RMS1) + m, XN + (size_t)m * DM, lane);
        { f16* WRT = (f16*)(ws + WS_WRT);
          for (int i = gw * 64 + lane; i < NEXP * DM; i += NGW * 64) { const int e = i >> 10, k = i & (DM - 1); const float w = w_router[k * NEXP + e] * norm2_g[k]; const f16 hi = (f16)w; WRT[i] = hi; WRT[NEXP * DM + i] = (f16)(w - (float)hi); } }
        __syncthreads();
    }
    SEAM_CV(PH_PRO);
    if (IN(PH_QKV)) REPS(PH_QKV) {
        REPBAR();
        pg8::SchedDense S; S.init(XN, WinT, MTOK, INW, DM, G, bx);
        pg8::EpiQKV E{PROJ, g_naq, g_nak, g_gq, g_gk};
        pg8::gemm_phase<pg8::EpiQKV, pg8::SchedDense, true, false>(lds, DM, S, E, wave);
    }
    SEAM_CV(PH_QKV);
    if (IN(PH_ATT)) REPS(PH_ATT) {
        REPBAR();
        for (int u = vcu; u < 256; u += G) {
            const int bkv = u >> 3, b = bkv >> 1, kvh = bkv & 1, qb = u & 7;
            f16x8 qfr[4];
#pragma unroll 1
            for (int i = 0; i < 4; ++i) { const int hq = kvh * 4 + i; const size_t row0 = (size_t)b * SEQ + qb * 256;
                attn_body::AttnU U{PROJ + row0 * INW + C_GQ + hq * 64, PROJ + (size_t)b * SEQ * INW + C_GK + kvh * 64, PROJ + (size_t)b * SEQ * INW + C_GV + kvh * 64,
                                   ATT + row0 * MIXW + 512 + hq * 64, SSQP + (size_t)(8 + hq) * MTOK + row0, 32, 0, 0, nullptr};
                const bool more = i < 3;
                attn_body::attn_unit<8, 0>(U, U.Qp + 64, more ? U.Kp : nullptr, U.Vp, i > 0, qfr, (char*)lds_raw, wave);
            }
        }
        asm volatile("" ::: "memory");
        for (int u = vcu; u < 256; u += G) {
            const int pr = u >> 1, b = pr >> 3, h = pr & 7;
            f16x8 qfrn[4];
#pragma unroll 1
            for (int i = 0; i < 4; ++i) { const int rb = (u & 1) * 4 + i, r0 = rb * 4; int kr0 = r0 - 4; kr0 = kr0 < 0 ? 0 : (kr0 > GROWS - 8 ? GROWS - 8 : kr0);
                const int NT = (rb == 0 || rb == 7) ? 8 : 12; const size_t row0 = (size_t)b * SEQ + r0 * GRIDW, krow0 = (size_t)b * SEQ + kr0 * GRIDW;
                attn_body::AttnU U{PROJ + row0 * INW + C_NAQ + h * 64, PROJ + krow0 * INW + C_NAK + h * 64, PROJ + krow0 * INW + C_NAV + h * 64,
                                   ATT + row0 * MIXW + h * 64, SSQP + (size_t)h * MTOK + row0, NT, r0, kr0, rpb + h * 465};
                const bool more = i < 3;
                int nkr0 = r0 + 4 - 4; nkr0 = nkr0 < 0 ? 0 : (nkr0 > GROWS - 8 ? GROWS - 8 : nkr0); const size_t nrow0 = (size_t)b * SEQ + (r0 + 4) * GRIDW, nkrow0 = (size_t)b * SEQ + nkr0 * GRIDW;
                attn_body::attn_unit<8, 1>(U, PROJ + nrow0 * INW + C_NAQ + h * 64, more ? PROJ + nkrow0 * INW + C_NAK + h * 64 : nullptr, PROJ + nkrow0 * INW + C_NAV + h * 64, i > 0, qfrn, (char*)lds_raw, wave);
            }
        }
    }
    SEAM_CV(PH_ATT);
    if (IN(PH_OUT)) REPS(PH_OUT) {
        REPBAR();
        pg8::SchedDense S; S.init(ATT, WoT, MTOK, DM, MIXW, G, bx);
        LAS f32x2* rab = (LAS f32x2*)(lds + RING_BYTES + 64);
        pg8::EpiOut E{XN, (const float*)(ws + WS_RMS1), H16, rab, SSQP, H8, (const f16*)(ws + WS_WRT), (float*)(ws + WS_PART), (float*)(ws + WS_SSQ2P), (unsigned*)(ctl + WS_PCNT), AFF, RSTD2, MISC};
        pg8::gemm_phase<pg8::EpiOut, pg8::SchedDense, true, false>(lds, MIXW, S, E, wave);
    }
    SEAM_CV(PH_OUT);
    if (IN(PH_TOPK)) REPS(PH_TOPK) { REPBAR();
        {
            const int lane = lane_id_v();
            if (wave == 0) for (int be = bx; be < NB * NEXP; be += G) topk_wave(AFF, RSTD2, IDX, RSS, GATE, INV, be, lane);
            LAS float* scr = (LAS float*)(lds + 4096 + wave * 16384);
            const int NGW = G * NWAVES;
            CV_SESSION(false);
            __syncthreads();
        } }
    SEAM(PH_TOPK);
    if (IN(PH_E1)) REPS(PH_E1) {
        REPBAR();
        pg8::SchedE1 S{(const char*)H8, (const char*)W1T, (const LAS unsigned short*)(lds + LDS_IDX16), G, vcu};
        {
            const int b_ = S.batch_of(), tid_ = wave * 64 + lane_id_v();
            LAS unsigned short* wi = (LAS unsigned short*)(lds + LDS_IDX16); LAS float* wr_ = (LAS float*)(lds + LDS_RSS);
            for (int i = tid_; i < NEXP * CAP; i += NWAVES * 64) { wi[i] = (unsigned short)IDX[b_ * NEXP * CAP + i]; wr_[i] = RSS[b_ * NEXP * CAP + i]; }
            __syncthreads();
        }
        pg8::EpiAct E{ACT, (const LAS float*)(lds + LDS_RSS)};
        pg8::gemm_phase<pg8::EpiAct, pg8::SchedE1, true, true>(lds, DM, S, E, wave);
    }
    SEAM(PH_E1);
    if (IN(PH_E2)) REPS(PH_E2) {
        REPBAR();
        pg8::SchedE2 S{(const char*)ACT, (const char*)W2T, G, vcu};
        pg8::EpiY E{Y, GATE};
        pg8::gemm_phase<pg8::EpiY, pg8::SchedE2, true, true>(lds, DEXP, S, E, wave);
    }
    SEAM(PH_E2);
    if (IN(PH_COMB)) REPS(PH_COMB) {
        REPBAR();
        const int lane = lane_id_v();
        const int gw = vcu * NWAVES + wave, NGW = G * NWAVES;
        for (int m = gw; m < MTOK; m += 2 * NGW) combine_rows2(out, H16, Y, INV, m, m + NGW, lane);
    }
    if (hi - lo > 1) {
        __syncthreads();
        if (leader) MISC[2] = (__hip_atomic_fetch_add(&g_ctl[CTL_EXIT], 1u, __ATOMIC_RELAXED, __HIP_MEMORY_SCOPE_AGENT) == (unsigned)G - 1u) ? 1u : 0u;
        __syncthreads();
        if (MISC[2]) { const int tid_ = wave * 64 + lane_id_v(); for (int i = tid_; i < (int)(CTL_ZERO_BYTES / 4); i += NWAVES * 64) __hip_atomic_store(&g_ctl[i], 0u, __ATOMIC_RELAXED, __HIP_MEMORY_SCOPE_AGENT); }
    }
#undef IN
#undef SEAM
}

#ifndef MEGA_MASK
#define MEGA_MASK 0x1FF
#endif
#ifndef ONE_LAUNCH
#define ONE_LAUNCH 1
#endif
static_assert(MEGA_MASK == 0x1FF && ONE_LAUNCH == 1, "the fp8 expert path needs the persistent-kernel forms of P0, P3, E1 and E2 (the simple kernels use the older f16 buffers)");
extern "C" void kernel_launch(void* const* d_in, const int* in_sizes, int n_in, void* d_out, int out_size, void* d_ws, size_t ws_size, hipStream_t stream) {
    static int grid = 0;
    if (grid == 0) {
        if (n_in != 16 || out_size != MTOK * DM || ws_size < WS_END) { fprintf(stderr, "kernel_launch: unexpected shapes (n_in %d out %d ws %zu, need %zu)\n", n_in, out_size, ws_size, (size_t)WS_END); grid = -1; return; }
        int dev = 0, cus = 0, per_cu = 0;
        if (hipGetDevice(&dev) != hipSuccess || hipDeviceGetAttribute(&cus, hipDeviceAttributeMultiprocessorCount, dev) != hipSuccess) { grid = -1; return; }
        if (hipFuncSetAttribute((const void*)mega_fwd, hipFuncAttributeMaxDynamicSharedMemorySize, LDS_TOTAL) != hipSuccess) { fprintf(stderr, "kernel_launch: hipFuncSetAttribute failed\n"); grid = -1; return; }
        if (hipOccupancyMaxActiveBlocksPerMultiprocessor(&per_cu, (const void*)mega_fwd, NWAVES * 64, LDS_TOTAL) != hipSuccess || per_cu < 1) { fprintf(stderr, "kernel_launch: occupancy query says %d\n", per_cu); per_cu = 1; }
        (void)hipGetLastError();
        grid = cus * 1;
        if (grid % 16 != 0 || grid < 64) { fprintf(stderr, "kernel_launch: %d CUs: the expert phase needs a grid that is a multiple of 16\n", cus); grid = -1; return; }
    }
    if (grid < 0) return;
    const float* x = (const float*)d_in[0]; const float* norm1_g = (const float*)d_in[1]; const float* w_in = (const float*)d_in[2];
    const float* g_naq = (const float*)d_in[3]; const float* g_nak = (const float*)d_in[4]; const float* rpb = (const float*)d_in[5];
    const float* g_gq = (const float*)d_in[6]; const float* g_gk = (const float*)d_in[7]; const float* g_oa = (const float*)d_in[8]; const float* g_ob = (const float*)d_in[9];
    const float* w_out = (const float*)d_in[10]; const float* norm2_g = (const float*)d_in[11]; const float* w_router = (const float*)d_in[12];
    const float* w_gate = (const float*)d_in[13]; const float* w_up = (const float*)d_in[14]; const float* w_down = (const float*)d_in[15];
    float* out = (float*)d_out; char* ws = (char*)d_ws;
    f16* XN = (f16*)(ws + WS_XN); f16* H16 = (f16*)(ws + WS_H16); f16* PROJ = (f16*)(ws + WS_PROJ); f16* ATT = (f16*)(ws + WS_ATT); f16* ACT = (f16*)(ws + WS_ACT); f16* Y = (f16*)(ws + WS_Y);
    float* SSQP = (float*)(ws + WS_SSQP); float* AFF = (float*)(ws + WS_AFF); float* RSTD2 = (float*)(ws + WS_RSTD2);
    int* IDX = (int*)(ws + WS_IDX); float* RSS = (float*)(ws + WS_RSS); float* GATE = (float*)(ws + WS_GATE); short* INV = (short*)(ws + WS_INV);
    f16* MIXED = (f16*)(ws + 560 * MiB);
    MArgs a{};
    for (int i = 0; i < 16; ++i) a.in[i] = (const float*)d_in[i];
    a.out = out; a.ws = (unsigned char*)d_ws;
    int p = 0;
    while (p < NPHASE) {
        if ((MEGA_MASK >> p) & 1) {
            int q = p + 1;
            if (ONE_LAUNCH) while (q < NPHASE && ((MEGA_MASK >> q) & 1)) ++q;
            a.ph_lo = p; a.ph_hi = q;
            void* kargs[] = {&a};
            hipError_t e = hipLaunchCooperativeKernel((const void*)mega_fwd, dim3(grid), dim3(NWAVES * 64), kargs, LDS_TOTAL, stream);
            if (e != hipSuccess) fprintf(stderr, "kernel_launch: cooperative launch failed: %s (grid %d)\n", hipGetErrorString(e), grid);
            p = q; continue;
        }
        switch (p) {
        case PH_PRO: k_rmsnorm1<<<MTOK / 4, 256, 0, stream>>>(x, norm1_g, XN); break;
        case PH_QKV: k_ngemm<1><<<dim3(INW / 64, MTOK / 64), 256, 0, stream>>>((long)DM, (const float*)nullptr, RpPlain{XN, DM, 0}, WpPlain{w_in, INW, 0}, EpiQKVn{PROJ, g_naq, g_nak, g_gq, g_gk}); break;
        case PH_ATT: k_nattn_gqa<<<dim3(SEQ / 64, GQH, NB), 64, 0, stream>>>(PROJ, ATT, SSQP); k_nattn_na<<<dim3(GROWS, NAH, NB), 64, 0, stream>>>(PROJ, rpb, ATT, SSQP); break;
        case PH_OUT: k_mixnorm<<<MTOK / 4, 256, 0, stream>>>(ATT, g_oa, g_ob, MIXED);
                     k_ngemm<1><<<dim3(DM / 64, MTOK / 64), 256, 0, stream>>>((long)MIXW, (const float*)nullptr, RpPlain{MIXED, MIXW, 0}, WpPlain{w_out, DM, 0}, EpiOutn{x, out, H16}); break;
        case PH_ROUTER: k_router<<<MTOK / 128, 512, 0, stream>>>(out, norm2_g, w_router, AFF, RSTD2); break;
        case PH_TOPK: k_topk<<<NB * NEXP, 512, 0, stream>>>(AFF, RSTD2, IDX, RSS, GATE, INV); break;
        case PH_E1: k_ngemm<2><<<dim3(DEXP / 64, NB * NEXP * CAP / 64), 256, 0, stream>>>((long)DM, norm2_g, RpGather{H16, IDX}, WpGU{w_gate, w_up}, EpiActn{ACT, RSS}); break;
        case PH_E2: k_ngemm<1><<<dim3(DM / 64, NB * NEXP * CAP / 64), 256, 0, stream>>>((long)DEXP, (const float*)nullptr, RpPlain{ACT, DEXP, 0}, WpDown{w_down}, EpiYn{Y, GATE}); break;
        case PH_COMB: k_combine<<<MTOK / 4, 256, 0, stream>>>(out, Y, INV); break;
        }
        ++p;
    }
}
```

```cpp
#include <hip/hip_runtime.h>
#include <cstdio>
#include <cstdint>

#define DEVI __device__ __forceinline__
typedef _Float16 f16;
typedef _Float16 f16x2 __attribute__((ext_vector_type(2)));
typedef _Float16 f16x4 __attribute__((ext_vector_type(4)));
typedef _Float16 f16x8 __attribute__((ext_vector_type(8)));
typedef float f32x2 __attribute__((ext_vector_type(2)));
typedef float f32x4 __attribute__((ext_vector_type(4)));
typedef unsigned u32x4 __attribute__((ext_vector_type(4)));
typedef unsigned u32x2 __attribute__((ext_vector_type(2)));
typedef int i32x4 __attribute__((ext_vector_type(4)));
typedef int i32x8 __attribute__((ext_vector_type(8)));

constexpr int NB = 16, SEQ = 2048, DM = 1024, MTOK = NB * SEQ;
constexpr int GRIDW = 64, GROWS = SEQ / GRIDW;
constexpr int HD = 64, NAH = 8, GQH = 8, GKV = 2;
constexpr int INW = 2304, MIXW = 1024;
constexpr int NEXP = 16, CAP = 256, DEXP = 2816;
constexpr int C_NAQ = 0, C_NAK = 512, C_NAV = 1024, C_GQ = 1536, C_GK = 2048, C_GV = 2176;
constexpr float EPS = 1e-6f;
constexpr float LOG2E = 1.4426950408889634f;
constexpr float C2 = 0.125f * LOG2E;

constexpr size_t MiB = 1u << 20;
constexpr size_t WS_CTL = 0;
constexpr size_t WS_SSQP = 2 * MiB;
constexpr size_t WS_AFF = 4 * MiB;
constexpr size_t WS_RSTD2 = 6 * MiB;
constexpr size_t WS_IDX = 7 * MiB;
constexpr size_t WS_RSS = 7 * MiB + 256 * 1024;
constexpr size_t WS_GATE = 7 * MiB + 512 * 1024;
constexpr size_t WS_INV = 8 * MiB;
constexpr size_t WS_WINT = 16 * MiB;
constexpr size_t WS_WOT = 22 * MiB;
constexpr size_t WS_W1T = 24 * MiB;
constexpr size_t WS_W2T = 112 * MiB;
constexpr size_t WS_H8 = 156 * MiB;
constexpr size_t WS_XN = 188 * MiB;
constexpr size_t WS_H16 = 188 * MiB;
constexpr size_t WS_PROJ = 252 * MiB;
constexpr size_t WS_ATT = 396 * MiB;
constexpr size_t WS_ACT = 252 * MiB;
constexpr size_t WS_Y = 460 * MiB;
constexpr size_t WS_PART = 600 * MiB;
constexpr size_t WS_SSQ2P = 640 * MiB;
constexpr size_t WS_RMS1 = 11 * MiB;
constexpr size_t WS_WRT = 10 * MiB;
constexpr size_t WS_PCNT = 16384;
constexpr size_t CTL_ZERO_BYTES = 65536;
constexpr float W_SCALE = 32.f, H_SCALE = 16.f, A_SCALE = 8.f, Y_SCALE = 32.f;
constexpr size_t WS_END = 704 * MiB;

struct RopeTab { float c[64][16]; float s[64][16]; };
constexpr double cx_exp(double x) {
    bool neg = x < 0; double y = neg ? -x : x; double term = 1.0, sum = 1.0;
    for (int i = 1; i < 80; ++i) { term *= y / i; sum += term; }
    return neg ? 1.0 / sum : sum;
}
constexpr double cx_sin(double r) { double term = r, sum = r; for (int i = 1; i < 20; ++i) { term *= -r * r / ((2 * i) * (2 * i + 1)); sum += term; } return sum; }
constexpr double cx_cos(double r) { double term = 1.0, sum = 1.0; for (int i = 1; i < 20; ++i) { term *= -r * r / ((2 * i - 1) * (2 * i)); sum += term; } return sum; }
constexpr RopeTab make_rope() {
    RopeTab t{};
    const double LN1E4 = 9.210340371976184, TWO_PI = 6.283185307179586476925;
    for (int j = 0; j < 16; ++j) {
        const double w = cx_exp(-(double)j / 16.0 * LN1E4);
        for (int p = 0; p < 64; ++p) {
            double a = (double)p * w; long k = (long)(a / TWO_PI + 0.5); double r = a - (double)k * TWO_PI;
            t.c[p][j] = (float)cx_cos(r); t.s[p][j] = (float)cx_sin(r);
        }
    }
    return t;
}
__device__ const RopeTab g_rope = make_rope();

#define DPP_ADD(v, ctrl) v += __builtin_bit_cast(float, __builtin_amdgcn_update_dpp(0, __builtin_bit_cast(int, v), ctrl, 0xF, 0xF, true))
DEVI float wave_sum(float v) {
    DPP_ADD(v, 0xB1);
    DPP_ADD(v, 0x4E);
    DPP_ADD(v, 0x141);
    DPP_ADD(v, 0x140);
    { auto r = __builtin_amdgcn_permlane16_swap(__float_as_uint(v), __float_as_uint(v), false, false); v = __uint_as_float(r[0]) + __uint_as_float(r[1]); }
    { auto r = __builtin_amdgcn_permlane32_swap(__float_as_uint(v), __float_as_uint(v), false, false); v = __uint_as_float(r[0]) + __uint_as_float(r[1]); }
    return v;
}
DEVI void h8_to_f(const u32x4 raw, float* f) {
    const f16x8 h = __builtin_bit_cast(f16x8, raw);
#pragma unroll
    for (int i = 0; i < 8; ++i) f[i] = (float)h[i];
}
DEVI float clamp448(float v) { return __builtin_fminf(__builtin_fmaxf(v, -448.f), 448.f); }
DEVI unsigned pk_f8x4(float a, float b, float c, float d) {
    int w = 0; w = __builtin_amdgcn_cvt_pk_fp8_f32(clamp448(a), clamp448(b), w, false); w = __builtin_amdgcn_cvt_pk_fp8_f32(clamp448(c), clamp448(d), w, true); return (unsigned)w; }
DEVI unsigned pk_h2(float a, float b) { f32x2 v = {a, b}; return __builtin_bit_cast(unsigned, __builtin_convertvector(v, f16x2)); }

__global__ __launch_bounds__(256) void k_rmsnorm1(const float* __restrict__ x, const float* __restrict__ g, f16* __restrict__ xn) {
    const int lane = threadIdx.x & 63, wave = threadIdx.x >> 6;
    const int row = blockIdx.x * 4 + wave;
    const f32x4* xr = (const f32x4*)(x + (size_t)row * DM) + lane;
    const f32x4* gr = (const f32x4*)g + lane;
    f32x4 v[4]; float s = 0.f;
#pragma unroll
    for (int j = 0; j < 4; ++j) { v[j] = xr[64 * j]; s += (v[j].x * v[j].x + v[j].y * v[j].y) + (v[j].z * v[j].z + v[j].w * v[j].w); }
    const float rstd = rsqrtf(wave_sum(s) * (1.f / DM) + EPS);
    u32x2* o = (u32x2*)(xn + (size_t)row * DM) + lane;
#pragma unroll
    for (int j = 0; j < 4; ++j) { const f32x4 gg = gr[64 * j]; u32x2 w; w.x = pk_h2(v[j].x * rstd * gg.x, v[j].y * rstd * gg.y); w.y = pk_h2(v[j].z * rstd * gg.z, v[j].w * rstd * gg.w); o[64 * j] = w; }
}

template <int NWM, class RowPtr, class WPtr, class Epi>
__global__ __launch_bounds__(256) void k_ngemm(long Kl, const float* __restrict__ kscale, RowPtr rp, WPtr wp, Epi epi) {
    const int K = (int)Kl;
    __shared__ float As[16][68];
    __shared__ float Ws[NWM][16][64];
    __shared__ float T[NWM][64][65];
    const int tid = threadIdx.x, ty = tid >> 4, tx = tid & 15, rt = blockIdx.y, ct = blockIdx.x;
    float acc[NWM][4][4];
#pragma unroll
    for (int w = 0; w < NWM; ++w)
#pragma unroll
        for (int i = 0; i < 4; ++i)
#pragma unroll
            for (int j = 0; j < 4; ++j) acc[w][i][j] = 0.f;
    const f16* arow = rp(rt, tid >> 2);
    const int ak = (tid & 3) * 4;
    int ldw = 0;
    const float* wb0 = wp(0, rt, ct, ldw);
    const float* wb1 = NWM > 1 ? wp(1, rt, ct, ldw) : wb0;
    for (int k0 = 0; k0 < K; k0 += 16) {
        const u32x2 av = *(const u32x2*)(arow + k0 + ak);
        const f16x4 ah = __builtin_bit_cast(f16x4, av);
#pragma unroll
        for (int i = 0; i < 4; ++i) As[ak + i][tid >> 2] = (float)ah[i] * (kscale ? kscale[k0 + ak + i] : 1.f);
        {
            const f32x4 wv = *(const f32x4*)(wb0 + (size_t)(k0 + (tid >> 4)) * ldw + (tid & 15) * 4);
            *(f32x4*)&Ws[0][tid >> 4][(tid & 15) * 4] = wv;
            if (NWM > 1) { const f32x4 wv1 = *(const f32x4*)(wb1 + (size_t)(k0 + (tid >> 4)) * ldw + (tid & 15) * 4); *(f32x4*)&Ws[NWM - 1][tid >> 4][(tid & 15) * 4] = wv1; }
        }
        __syncthreads();
#pragma unroll
        for (int k = 0; k < 16; ++k) {
            const f32x4 a = *(const f32x4*)&As[k][ty * 4];
#pragma unroll
            for (int w = 0; w < NWM; ++w) {
                const f32x4 b = *(const f32x4*)&Ws[w][k][tx * 4];
#pragma unroll
                for (int i = 0; i < 4; ++i)
#pragma unroll
                    for (int j = 0; j < 4; ++j) acc[w][i][j] += a[i] * b[j];
            }
        }
        __syncthreads();
    }
#pragma unroll
    for (int w = 0; w < NWM; ++w)
#pragma unroll
        for (int i = 0; i < 4; ++i)
#pragma unroll
            for (int j = 0; j < 4; ++j) T[w][ty * 4 + i][tx * 4 + j] = acc[w][i][j];
    __syncthreads();
    epi(T, rt, ct, tid);
}

struct RpPlain { const f16* A; int lda; int pad; DEVI const f16* operator()(int rt, int r) const { return A + (size_t)(rt * 64 + r) * lda; } };
struct WpPlain { const float* W; int ldw_; int pad; DEVI const float* operator()(int, int, int ct, int& ldw) const { ldw = ldw_; return W + ct * 64; } };
struct EpiQKVn {
    f16* proj; const float *g_naq, *g_nak, *g_gq, *g_gk;
    DEVI void operator()(float (*T)[64][65], int rt, int ct, int tid) const {
        const int row = tid >> 2, q4 = tid & 3, grow = rt * 64 + row, hs = ct;
        float v[16];
#pragma unroll
        for (int i = 0; i < 16; ++i) v[i] = T[0][row][q4 * 16 + i];
        const float* g = nullptr; bool rope = false; float sc = 1.f;
        if (hs < 8) { g = g_naq; sc = C2; } else if (hs < 16) { g = g_nak; } else if (hs < 24) { } else if (hs < 32) { g = g_gq; rope = true; sc = C2; } else if (hs < 34) { g = g_gk; rope = true; }
        if (g) {
            float ssq = 0.f;
#pragma unroll
            for (int i = 0; i < 16; ++i) ssq += v[i] * v[i];
            ssq += __shfl_xor(ssq, 1); ssq += __shfl_xor(ssq, 2);
            const float rstd = rsqrtf(ssq * (1.f / 64.f) + EPS);
#pragma unroll
            for (int i = 0; i < 16; ++i) v[i] = v[i] * rstd * g[q4 * 16 + i];
        }
        if (rope) {
            const int t = grow & (SEQ - 1), pos = (q4 < 2) ? (t >> 6) : (t & 63);
#pragma unroll
            for (int i = 0; i < 8; ++i) { const int j = (q4 & 1) * 8 + i; const float c = g_rope.c[pos][j], s = g_rope.s[pos][j]; const float x0 = v[2 * i], x1 = v[2 * i + 1]; v[2 * i] = x0 * c - x1 * s; v[2 * i + 1] = x0 * s + x1 * c; }
        }
        f16* o = proj + (size_t)grow * INW + hs * 64 + q4 * 16;
#pragma unroll
        for (int i = 0; i < 16; ++i) o[i] = (f16)(v[i] * sc);
    }
};

__global__ __launch_bounds__(256) void k_mixnorm(const f16* __restrict__ att, const float* __restrict__ ga, const float* __restrict__ gb, f16* __restrict__ mixed) {
    const int lane = threadIdx.x & 63, wave = threadIdx.x >> 6; const int row = blockIdx.x * 4 + wave;
    const u32x4* a = (const u32x4*)(att + (size_t)row * MIXW + lane * 16);
    float v[16]; h8_to_f(a[0], v); h8_to_f(a[1], v + 8);
    float s = 0.f;
#pragma unroll
    for (int i = 0; i < 16; ++i) s += v[i] * v[i];
#pragma unroll
    for (int o = 1; o < 32; o <<= 1) s += __shfl_xor(s, o);
    const float rstd = rsqrtf(s * (1.f / 512.f) + EPS);
    const float* g = (lane < 32 ? ga : gb) + (lane & 31) * 16;
    u32x4 w0, w1;
    w0.x = pk_h2(v[0] * rstd * g[0], v[1] * rstd * g[1]); w0.y = pk_h2(v[2] * rstd * g[2], v[3] * rstd * g[3]); w0.z = pk_h2(v[4] * rstd * g[4], v[5] * rstd * g[5]); w0.w = pk_h2(v[6] * rstd * g[6], v[7] * rstd * g[7]);
    w1.x = pk_h2(v[8] * rstd * g[8], v[9] * rstd * g[9]); w1.y = pk_h2(v[10] * rstd * g[10], v[11] * rstd * g[11]); w1.z = pk_h2(v[12] * rstd * g[12], v[13] * rstd * g[13]); w1.w = pk_h2(v[14] * rstd * g[14], v[15] * rstd * g[15]);
    u32x4* o = (u32x4*)(mixed + (size_t)row * MIXW + lane * 16); o[0] = w0; o[1] = w1;
}
struct EpiOutn {
    const float* x; float* out; f16* h16;
    DEVI void operator()(float (*T)[64][65], int rt, int ct, int tid) const {
        const int row = tid >> 2, q4 = tid & 3; const size_t off = (size_t)(rt * 64 + row) * DM + ct * 64 + q4 * 16;
#pragma unroll
        for (int i = 0; i < 16; ++i) { const float h = x[off + i] + T[0][row][q4 * 16 + i]; out[off + i] = h; h16[off + i] = (f16)h; }
    }
};

struct RpGather { const f16* H; const int* idx; DEVI const f16* operator()(int rt, int r) const { const int panel = rt >> 2, slot = (rt & 3) * 64 + r, b = panel >> 4; return H + ((size_t)b * SEQ + idx[panel * CAP + slot]) * DM; } };
struct WpGU { const float *Wg, *Wu; DEVI const float* operator()(int w, int rt, int ct, int& ldw) const { const int e = (rt >> 2) & 15; ldw = DEXP; return (w ? Wu : Wg) + (size_t)e * DM * DEXP + ct * 64; } };
struct EpiActn {
    f16* act; const float* rss;
    DEVI void operator()(float (*T)[64][65], int rt, int ct, int tid) const {
        const int row = tid >> 2, q4 = tid & 3; const size_t prow = (size_t)rt * 64 + row; const float rs = rss[prow];
        f16* o = act + prow * DEXP + ct * 64 + q4 * 16;
#pragma unroll
        for (int i = 0; i < 16; ++i) { const float g = T[0][row][q4 * 16 + i] * rs, u = T[1][row][q4 * 16 + i] * rs; o[i] = (f16)(g / (1.f + __expf(-g)) * u); }
    }
};
struct WpDown { const float* Wd; DEVI const float* operator()(int, int rt, int ct, int& ldw) const { const int e = (rt >> 2) & 15; ldw = DM; return Wd + (size_t)e * DEXP * DM + ct * 64; } };
struct EpiYn {
    f16* y; const float* gate;
    DEVI void operator()(float (*T)[64][65], int rt, int ct, int tid) const {
        const int row = tid >> 2, q4 = tid & 3; const size_t prow = (size_t)rt * 64 + row; const float gt = gate[prow];
        f16* o = y + prow * DM + ct * 64 + q4 * 16;
#pragma unroll
        for (int i = 0; i < 16; ++i) o[i] = (f16)(T[0][row][q4 * 16 + i] * gt);
    }
};

__global__ __launch_bounds__(64) void k_nattn_gqa(const f16* __restrict__ proj, f16* __restrict__ att, float* __restrict__ ssqp) {
    __shared__ float Ks[64][64];
    __shared__ float Vs[64][64];
    const int t = threadIdx.x, qi = blockIdx.x * 64 + t, h = blockIdx.y, b = blockIdx.z, kvh = h >> 2;
    const size_t row = (size_t)b * SEQ + qi;
    float q[64], o[64];
    { const u32x4* qp = (const u32x4*)(proj + row * INW + C_GQ + h * 64);
#pragma unroll
      for (int c = 0; c < 8; ++c) h8_to_f(qp[c], q + 8 * c); }
#pragma unroll
    for (int d = 0; d < 64; ++d) o[d] = 0.f;
    float m = -1e30f, l = 0.f;
    for (int kt = 0; kt < SEQ / 64; ++kt) {
        __syncthreads();
#pragma unroll
        for (int c = 0; c < 8; ++c) {
            const int chunk = c * 64 + t, key = chunk >> 3, part = chunk & 7;
            const size_t krow = (size_t)b * SEQ + kt * 64 + key;
            float f[8];
            h8_to_f(*(const u32x4*)(proj + krow * INW + C_GK + kvh * 64 + part * 8), f);
#pragma unroll
            for (int i = 0; i < 8; ++i) Ks[key][part * 8 + i] = f[i];
            h8_to_f(*(const u32x4*)(proj + krow * INW + C_GV + kvh * 64 + part * 8), f);
#pragma unroll
            for (int i = 0; i < 8; ++i) Vs[key][part * 8 + i] = f[i];
        }
        __syncthreads();
        for (int j = 0; j < 64; ++j) {
            float s = 0.f;
#pragma unroll
            for (int d = 0; d < 64; ++d) s += q[d] * Ks[j][d];
            if (s > m) { const float a = exp2f(m - s); l *= a;
#pragma unroll
                for (int d = 0; d < 64; ++d) o[d] *= a;
                m = s; }
            const float p = exp2f(s - m); l += p;
#pragma unroll
            for (int d = 0; d < 64; ++d) o[d] += p * Vs[j][d];
        }
    }
    const float inv = 1.f / l; float ssq = 0.f;
    f16* op = att + row * MIXW + 512 + h * 64;
#pragma unroll
    for (int d = 0; d < 64; ++d) { const f16 hv = (f16)(o[d] * inv); op[d] = hv; const float r = (float)hv; ssq += r * r; }
    ssqp[row * 16 + 8 + h] = ssq;
}
__global__ __launch_bounds__(64) void k_nattn_na(const f16* __restrict__ proj, const float* __restrict__ rpb, f16* __restrict__ att, float* __restrict__ ssqp) {
    const int c = threadIdx.x, r = blockIdx.x, h = blockIdx.y, b = blockIdx.z;
    const size_t row = (size_t)b * SEQ + r * GRIDW + c;
    int rs = r - 4; rs = rs < 0 ? 0 : (rs > GROWS - 8 ? GROWS - 8 : rs);
    int cs = c - 8; cs = cs < 0 ? 0 : (cs > GRIDW - 16 ? GRIDW - 16 : cs);
    float q[64], o[64];
    { const u32x4* qp = (const u32x4*)(proj + row * INW + C_NAQ + h * 64);
#pragma unroll
      for (int cc = 0; cc < 8; ++cc) h8_to_f(qp[cc], q + 8 * cc); }
#pragma unroll
    for (int d = 0; d < 64; ++d) o[d] = 0.f;
    float m = -1e30f, l = 0.f;
    for (int kr = rs; kr < rs + 8; ++kr)
        for (int kc = cs; kc < cs + 16; ++kc) {
            const size_t krow = (size_t)b * SEQ + kr * GRIDW + kc;
            const u32x4* kp = (const u32x4*)(proj + krow * INW + C_NAK + h * 64);
            float s = 0.f;
#pragma unroll
            for (int cc = 0; cc < 8; ++cc) { float f[8]; h8_to_f(kp[cc], f);
#pragma unroll
                for (int i = 0; i < 8; ++i) s += q[8 * cc + i] * f[i]; }
            s += rpb[(h * 15 + (kr - r + 7)) * 31 + (kc - c + 15)] * LOG2E;
            if (s > m) { const float a = exp2f(m - s); l *= a;
#pragma unroll
                for (int d = 0; d < 64; ++d) o[d] *= a;
                m = s; }
            const float p = exp2f(s - m); l += p;
            const u32x4* vp = (const u32x4*)(proj + krow * INW + C_NAV + h * 64);
#pragma unroll
            for (int cc = 0; cc < 8; ++cc) { float f[8]; h8_to_f(vp[cc], f);
#pragma unroll
                for (int i = 0; i < 8; ++i) o[8 * cc + i] += p * f[i]; }
        }
    const float inv = 1.f / l; float ssq = 0.f;
    f16* op = att + row * MIXW + h * 64;
#pragma unroll
    for (int d = 0; d < 64; ++d) { const f16 hv = (f16)(o[d] * inv); op[d] = hv; const float rr = (float)hv; ssq += rr * rr; }
    ssqp[row * 16 + h] = ssq;
}

__global__ __launch_bounds__(512) void k_router(const float* __restrict__ h, const float* __restrict__ g2, const float* __restrict__ wr, float* __restrict__ aff, float* __restrict__ rstd2) {
    __shared__ f32x4 wr4[DM * 4];
    const int tid = threadIdx.x, lane = tid & 63, wave = tid >> 6;
    for (int i = tid; i < DM * 4; i += 512) { const int k = i >> 2, c4 = i & 3; const f32x4 w = ((const f32x4*)wr)[i] * g2[k]; wr4[k * 4 + (c4 ^ ((k >> 2) & 3))] = w; }
    __syncthreads();
    const int sw = (lane >> 2) & 3;
    for (int r = 0; r < 16; ++r) {
        const int t = blockIdx.x * 128 + wave * 16 + r;
        const float* hrow = h + (size_t)t * DM;
        float ssq = 0.f;
        float lg[16];
#pragma unroll
        for (int e = 0; e < 16; ++e) lg[e] = 0.f;
#pragma unroll 2
        for (int i = 0; i < 16; ++i) {
            const int k = lane + 64 * i; const float hv = hrow[k]; ssq += hv * hv;
#pragma unroll
            for (int c4 = 0; c4 < 4; ++c4) { const f32x4 w = wr4[k * 4 + (c4 ^ sw)]; lg[4 * c4 + 0] += hv * w.x; lg[4 * c4 + 1] += hv * w.y; lg[4 * c4 + 2] += hv * w.z; lg[4 * c4 + 3] += hv * w.w; }
        }
        const float rs = rsqrtf(wave_sum(ssq) * (1.f / DM) + EPS);
        float mx = -1e30f;
#pragma unroll
        for (int e = 0; e < 16; ++e) { lg[e] = wave_sum(lg[e]) * rs; mx = fmaxf(mx, lg[e]); }
        float sum = 0.f;
#pragma unroll
        for (int e = 0; e < 16; ++e) { lg[e] = __expf(lg[e] - mx); sum += lg[e]; }
        float mine = 0.f;
#pragma unroll
        for (int e = 0; e < 16; ++e) mine = (lane == e) ? lg[e] : mine;
        const int b = t >> 11, tt = t & (SEQ - 1);
        if (lane < 16) aff[((size_t)b * NEXP + lane) * SEQ + tt] = mine / sum;
        if (lane == 0) rstd2[t] = rs;
    }
}

DEVI int block_sum512(int v, int* red, int tid) {
    const int lane = tid & 63, wave = tid >> 6;
#pragma unroll
    for (int o = 1; o < 64; o <<= 1) v += __shfl_xor(v, o);
    if (lane == 0) red[wave] = v;
    __syncthreads();
    int s = 0;
#pragma unroll
    for (int w = 0; w < 8; ++w) s += red[w];
    return s;
}
DEVI int block_excl_scan512(int v, int* red, int tid) {
    const int lane = tid & 63, wave = tid >> 6;
    int inc = v;
#pragma unroll
    for (int o = 1; o < 64; o <<= 1) { const int n = __shfl_up(inc, o); if (lane >= o) inc += n; }
    if (lane == 63) red[wave] = inc;
    __syncthreads();
    int base = 0;
#pragma unroll
    for (int w = 0; w < 8; ++w) base += (w < wave) ? red[w] : 0;
    return base + inc - v;
}
__global__ __launch_bounds__(512) void k_topk(const float* __restrict__ aff, const float* __restrict__ rstd2, int* __restrict__ idx, float* __restrict__ rss, float* __restrict__ gate, short* __restrict__ inv) {
    __shared__ int red[4][8];
    const int tid = threadIdx.x, be = blockIdx.x, b = be >> 4, e = be & 15;
    const f32x4 a4 = ((const f32x4*)(aff + (size_t)be * SEQ))[tid];
    const float av[4] = {a4.x, a4.y, a4.z, a4.w};
    unsigned bits[4];
#pragma unroll
    for (int j = 0; j < 4; ++j) bits[j] = __float_as_uint(av[j]);
    unsigned lo = 0u, hi = 0x7f800000u;
    int it = 0;
    while (lo < hi) {
        const unsigned mid = lo + ((hi - lo + 1u) >> 1);
        int c = 0;
#pragma unroll
        for (int j = 0; j < 4; ++j) c += (bits[j] >= mid) ? 1 : 0;
        const int tot = block_sum512(c, red[it & 1], tid);
        if (tot >= CAP) lo = mid; else hi = mid - 1u;
        ++it;
    }
    const unsigned theta = lo;
    int cgt = 0, ceq = 0;
#pragma unroll
    for (int j = 0; j < 4; ++j) { cgt += (bits[j] > theta) ? 1 : 0; ceq += (bits[j] == theta) ? 1 : 0; }
    const int ngt = block_sum512(cgt, red[2], tid);
    const int need = CAP - ngt;
    int eqr = block_excl_scan512(ceq, red[3], tid);
    int sel[4]; int csel = 0;
#pragma unroll
    for (int j = 0; j < 4; ++j) { const bool eq = bits[j] == theta; sel[j] = (bits[j] > theta || (eq && eqr < need)) ? 1 : 0; eqr += eq ? 1 : 0; csel += sel[j]; }
    __syncthreads();
    int slot = block_excl_scan512(csel, red[0], tid);
#pragma unroll
    for (int j = 0; j < 4; ++j) {
        const int t = 4 * tid + j;
        short s = -1;
        if (sel[j]) { s = (short)slot; idx[be * CAP + slot] = t; gate[be * CAP + slot] = av[j]; rss[be * CAP + slot] = rstd2[b * SEQ + t]; ++slot; }
        inv[((size_t)b * SEQ + t) * NEXP + e] = s;
    }
}

__global__ __launch_bounds__(256) void k_combine(float* __restrict__ out, const f16* __restrict__ y, const short* __restrict__ inv) {
    const int lane = threadIdx.x & 63, wave = threadIdx.x >> 6; const int row = blockIdx.x * 4 + wave, b = row >> 11;
    f32x4* orow = (f32x4*)(out + (size_t)row * DM) + lane;
    f32x4 v[4];
#pragma unroll
    for (int j = 0; j < 4; ++j) v[j] = orow[64 * j];
    const short* iv = inv + (size_t)row * NEXP;
    for (int e = 0; e < NEXP; ++e) {
        const int s = iv[e];
        if (s >= 0) {
            const u32x2* yr = (const u32x2*)(y + ((size_t)(b * NEXP + e) * CAP + s) * DM) + lane;
#pragma unroll
            for (int j = 0; j < 4; ++j) { const f16x4 hh = __builtin_bit_cast(f16x4, yr[64 * j]); v[j].x += (float)hh[0]; v[j].y += (float)hh[1]; v[j].z += (float)hh[2]; v[j].w += (float)hh[3]; }
        }
    }
#pragma unroll
    for (int j = 0; j < 4; ++j) orow[64 * j] = v[j];
}


#define LAS __attribute__((address_space(3)))
#define GAS __attribute__((address_space(1)))
#define WAIT_V(n) asm volatile("s_waitcnt vmcnt(" #n ")" ::: "memory")
#define WAIT_L(n) asm volatile("s_waitcnt lgkmcnt(" #n ")" ::: "memory")
#define SBAR_RAW __builtin_amdgcn_s_barrier()
#define SCHED0 __builtin_amdgcn_sched_barrier(0)
DEVI int lane_id_v() { int l; asm volatile("v_mbcnt_lo_u32_b32 %0, -1, 0\n\tv_mbcnt_hi_u32_b32 %0, -1, %0" : "=v"(l)); return l; }

namespace pg8 {
constexpr int BM = 256, BK = 64, HALF = 128, HTB = HALF * BK * 2, STAGE_BYTES = 8 * HTB;
__host__ __device__ __forceinline__ int lds_byte(int r, int c) { const int st = (r >> 4) * 2 + (c >> 5), rr = r & 15, cc = c & 31, ob = rr * 64 + cc * 2; return st * 1024 + (ob ^ (((ob >> 9) & 1) << 5)); }
__host__ __device__ __forceinline__ void stage_rc(int b, int& R, int& C) { const int st = b / 1024, sb = b % 1024, swz = sb ^ (((sb >> 9) & 1) << 5); R = (st >> 1) * 16 + swz / 64; C = (st & 1) * 32 + (swz % 64) / 2; }
__host__ __device__ __forceinline__ int sigma_inv(int cl) { return 128 * ((cl >> 5) & 1) + 32 * (cl >> 6) + 16 * ((cl >> 2) & 1) + 4 * ((cl >> 3) & 3) + (cl & 3); }

struct Unit { int pm, pn, aux; };

template <class Epi, class Sched, bool ALIGN_EPI, bool FP8>
DEVI void gemm_phase(LAS unsigned char* lds, const int K, const Sched& S, const Epi& E, const int wid) {
    const int lane = lane_id_v(), tid = wid * 64 + lane, wr = wid >> 2, wc = wid & 3, fr = lane & 15, fq = lane >> 4;
    const int nt = K * (FP8 ? 1 : 2) / 128;
    const int RBA = S.a_pitch(), RBB = S.b_pitch();
    const size_t kstepA = S.a_kstep(), kstepB = S.b_kstep();
    int sR[2], sC[2];
    unsigned voffB[2];
#pragma unroll
    for (int i = 0; i < 2; ++i) { stage_rc(tid * 16 + i * 8192, sR[i], sC[i]); voffB[i] = (unsigned)(sR[i] * RBB + sC[i] * 2); }
    const size_t hstep = (size_t)HALF * RBB;
    const unsigned ldsw = (unsigned)wid * 1024u;
    const int aoff = lds_byte(wr * 64 + fr, fq * 8), boff = lds_byte(wc * 32 + fr, fq * 8);
    LAS unsigned char* const ldsA = lds + aoff; LAS unsigned char* const ldsB = lds + 4 * HTB + boff;
#define PG8_SA(b, h) (((b) * 2 + (h)) * HTB)
#define PG8_SB(b, h) ((4 + (b) * 2 + (h)) * HTB)
#define PG8_STAGE(bufoff, gbase, v0, v1) do { \
        __builtin_amdgcn_global_load_lds((const unsigned*)((const char*)(gbase) + (v0)), (LAS unsigned*)(lds + (bufoff) + ldsw), 16, 0, 0); \
        __builtin_amdgcn_global_load_lds((const unsigned*)((const char*)(gbase) + (v1)), (LAS unsigned*)(lds + (bufoff) + ldsw + 8192), 16, 0, 0); } while (0)
#define PG8_LDF(base_, off_) (*(const LAS f16x8*)((base_) + (off_)))
#define PG8_LDA(dst, b, h) do { _Pragma("unroll") for (int m = 0; m < 4; ++m) { \
        if constexpr (FP8) dst##8[m] = PG8_CAT(PG8_LDF(ldsA, PG8_SA(b, h) + m * 2048), PG8_LDF(ldsA, PG8_SA(b, h) + m * 2048 + 1024)); \
        else { _Pragma("unroll") for (int k = 0; k < 2; ++k) dst[m][k] = PG8_LDF(ldsA, PG8_SA(b, h) + m * 2048 + k * 1024); } } } while (0)
#define PG8_LDB(dst, b, h) do { _Pragma("unroll") for (int n = 0; n < 2; ++n) { \
        if constexpr (FP8) dst##8[n] = PG8_CAT(PG8_LDF(ldsB, PG8_SB(b, h) - 4 * HTB + n * 2048), PG8_LDF(ldsB, PG8_SB(b, h) - 4 * HTB + n * 2048 + 1024)); \
        else { _Pragma("unroll") for (int k = 0; k < 2; ++k) dst[n][k] = PG8_LDF(ldsB, PG8_SB(b, h) - 4 * HTB + n * 2048 + k * 1024); } } } while (0)
#define PG8_CAT(lo_, hi_) __builtin_shufflevector(__builtin_bit_cast(i32x4, lo_), __builtin_bit_cast(i32x4, hi_), 0, 1, 2, 3, 4, 5, 6, 7)
#define PG8_MMA(ai, bj, At, Bt) do { __builtin_amdgcn_s_setprio(1); _Pragma("unroll") for (int m = 0; m < 4; ++m) _Pragma("unroll") for (int n = 0; n < 2; ++n) { \
        if constexpr (FP8) asm volatile("v_mfma_f32_16x16x128_f8f6f4 %0, %1, %2, %0" : "+v"(acc[ai][bj][m][n]) : "v"(Bt##8[n]), "v"(At##8[m]));   \
        else { _Pragma("unroll") for (int k = 0; k < 2; ++k) acc[ai][bj][m][n] = __builtin_amdgcn_mfma_f32_16x16x32_f16(Bt[n][k], At[m][k], acc[ai][bj][m][n], 0, 0, 0); } } \
        __builtin_amdgcn_s_setprio(0); } while (0)
    Unit cur, nxt; int ui = 0;
    if (!S.next(0, cur)) return;
    f32x4 acc[2][2][4][2];
#pragma unroll
    for (int a = 0; a < 2; ++a)
#pragma unroll
        for (int b = 0; b < 2; ++b)
#pragma unroll
            for (int m = 0; m < 4; ++m)
#pragma unroll
                for (int n = 0; n < 2; ++n) acc[a][b][m][n] = (f32x4){0.f, 0.f, 0.f, 0.f};
    f16x8 At[4][2], B0[2][2], B1[2][2];
    const int one_scale = 0x7f7f7f7f;
    i32x8 At8[4], B08[2], B18[2];
    const char* cA = S.a_base(cur); const char* cB = S.b_base(cur);
    unsigned vA00, vA01, vA10, vA11, nA00, nA01, nA10, nA11;
    vA00 = S.a_off(cur, sR[0], sC[0] * 2); vA01 = S.a_off(cur, sR[1], sC[1] * 2);
    vA10 = S.a_off(cur, HALF + sR[0], sC[0] * 2); vA11 = S.a_off(cur, HALF + sR[1], sC[1] * 2);
    nA00 = vA00; nA01 = vA01; nA10 = vA10; nA11 = vA11;
    PG8_STAGE(PG8_SB(0, 0), cB, voffB[0], voffB[1]); PG8_STAGE(PG8_SB(0, 1), cB + hstep, voffB[0], voffB[1]); PG8_STAGE(PG8_SA(0, 0), cA, vA00, vA01); PG8_STAGE(PG8_SA(0, 1), cA, vA10, vA11);
    if (wr == 1) SBAR_RAW;
    WAIT_V(2); SBAR_RAW;
    PG8_STAGE(PG8_SB(1, 0), cB + kstepB, voffB[0], voffB[1]); PG8_STAGE(PG8_SA(1, 0), cA + kstepA, vA00, vA01); PG8_STAGE(PG8_SB(1, 1), cB + hstep + kstepB, voffB[0], voffB[1]);
    WAIT_V(6); SBAR_RAW;
    for (;;) {
        const bool has_next = S.next(ui + 1, nxt);
        const char* nA = has_next ? S.a_base(nxt) : cA; const char* nB = has_next ? S.b_base(nxt) : cB;
#pragma unroll 1
        for (int t = 0; t < nt; t += 2) {
            const bool last = (t == nt - 2);
            if (Epi::HAS_MID) { if (t == (nt >> 1)) E.mid(acc, cur, wr, wc, fr, fq); }
            if (Sched::GATHER) { if (last && has_next) {
                nA00 = S.a_off(nxt, sR[0], sC[0] * 2); nA01 = S.a_off(nxt, sR[1], sC[1] * 2);
                nA10 = S.a_off(nxt, HALF + sR[0], sC[0] * 2); nA11 = S.a_off(nxt, HALF + sR[1], sC[1] * 2); } }
            const char* a1 = cA + (size_t)(t + 1) * kstepA;
            const char* a2 = last ? nA : cA + (size_t)(t + 2) * kstepA; const char* b2 = last ? nB : cB + (size_t)(t + 2) * kstepB;
            const char* a3 = a2 + kstepA; const char* b3 = b2 + kstepB;
            const unsigned w00 = (Sched::GATHER && last) ? nA00 : vA00, w01 = (Sched::GATHER && last) ? nA01 : vA01, w10 = (Sched::GATHER && last) ? nA10 : vA10, w11 = (Sched::GATHER && last) ? nA11 : vA11;
            PG8_LDB(B0, 0, 0); PG8_LDB(B1, 0, 1); SCHED0; PG8_LDA(At, 0, 0); PG8_STAGE(PG8_SA(1, 1), a1, vA10, vA11);
            WAIT_V(8); WAIT_L(0); SBAR_RAW; PG8_MMA(0, 0, At, B0); PG8_MMA(0, 1, At, B1); SBAR_RAW; SCHED0;
            PG8_LDA(At, 0, 1); PG8_STAGE(PG8_SB(0, 0), b2, voffB[0], voffB[1]); PG8_STAGE(PG8_SB(0, 1), b2 + hstep, voffB[0], voffB[1]); PG8_STAGE(PG8_SA(0, 0), a2, w00, w01);
            WAIT_V(8); WAIT_L(0); SBAR_RAW; PG8_MMA(1, 0, At, B0); PG8_MMA(1, 1, At, B1); SBAR_RAW; SCHED0;
            PG8_LDB(B0, 1, 0); PG8_LDB(B1, 1, 1); SCHED0; PG8_LDA(At, 1, 0); PG8_STAGE(PG8_SA(0, 1), a2, w10, w11);
            WAIT_V(8); WAIT_L(0); SBAR_RAW; PG8_MMA(0, 0, At, B0); PG8_MMA(0, 1, At, B1); SBAR_RAW; SCHED0;
            PG8_LDA(At, 1, 1); PG8_STAGE(PG8_SB(1, 0), b3, voffB[0], voffB[1]); PG8_STAGE(PG8_SB(1, 1), b3 + hstep, voffB[0], voffB[1]); PG8_STAGE(PG8_SA(1, 0), a3, w00, w01);
            WAIT_V(8); WAIT_L(0); SBAR_RAW; PG8_MMA(1, 0, At, B0); PG8_MMA(1, 1, At, B1); SBAR_RAW; SCHED0;
        }
        if constexpr (ALIGN_EPI) { if (wr == 0) SBAR_RAW; }
        if constexpr (FP8) asm volatile("s_nop 15\n\ts_nop 7" ::: "memory");
        E(acc, cur, wr, wc, fr, fq);
        if (!has_next) break;
#pragma unroll
        for (int a = 0; a < 2; ++a)
#pragma unroll
            for (int b = 0; b < 2; ++b)
#pragma unroll
                for (int m = 0; m < 4; ++m)
#pragma unroll
                    for (int n = 0; n < 2; ++n) acc[a][b][m][n] = (f32x4){0.f, 0.f, 0.f, 0.f};
        cur = nxt; cA = nA; cB = nB; ++ui;
        if (Sched::GATHER) { vA00 = nA00; vA01 = nA01; vA10 = nA10; vA11 = nA11; }
        if constexpr (ALIGN_EPI) { if (wr == 1) SBAR_RAW; }
    }
    WAIT_V(0);
    if constexpr (!ALIGN_EPI) { if (wr == 0) SBAR_RAW; }
    SBAR_RAW;
#undef PG8_SA
#undef PG8_SB
#undef PG8_STAGE
#undef PG8_LDA
#undef PG8_LDF
#undef PG8_LDB
#undef PG8_MMA
#undef PG8_CAT
}

constexpr int NXCD = 8, WGM = 8;
struct SchedDense {
    static constexpr bool GATHER = false;
    const char* A; const char* Bt; int nM, nN, nwg, G, c; size_t tstep;
    DEVI void init(const void* A_, const void* Bt_, int M, int N, int K, int G_, int c_) { A = (const char*)A_; Bt = (const char*)Bt_; nM = M / BM; nN = N / BM; nwg = nM * nN; G = G_; c = c_; tstep = (size_t)BM * K * 2; }
    DEVI bool next(int i, Unit& u) const {
        const long L = (long)i * G + c; if (L >= nwg) return false;
        int wgid = (int)L; { const int q = nwg / NXCD, r = nwg % NXCD, xcd = wgid % NXCD, off = wgid / NXCD; wgid = (xcd < r ? xcd * (q + 1) : r * (q + 1) + (xcd - r) * q) + off; }
        const int nig = WGM * nN, gid = wgid / nig, fm = gid * WGM, gsz = (nM - fm) < WGM ? (nM - fm) : WGM;
        u.pm = fm + ((wgid % nig) % gsz); u.pn = (wgid % nig) / gsz; u.aux = i; return true;
    }
    DEVI const char* a_base(const Unit& u) const { return A + (size_t)u.pm * tstep; }
    DEVI const char* b_base(const Unit& u) const { return Bt + (size_t)u.pn * tstep; }
    DEVI unsigned a_off(const Unit&, int r, int cb) const { return (unsigned)(r * (int)(tstep / BM) + cb); }
    DEVI int a_pitch() const { return (int)(tstep / BM); } DEVI int b_pitch() const { return (int)(tstep / BM); } DEVI size_t a_kstep() const { return 128; } DEVI size_t b_kstep() const { return 128; }
};
struct SchedE1 {
    static constexpr bool GATHER = true;
    const char* H; const char* W1; const LAS unsigned short* lidx; int G, vcu;
    DEVI int batch_of() const { if (G == 256) { const int x = vcu >> 5, y = vcu & 31; return (x & 3) * 4 + (y & 3); } return vcu & 15; }
    DEVI bool next(int i, Unit& u) const {
        int ep;
        if (G == 256) { if (i >= 22) return false; const int x = vcu >> 5, y = vcu & 31; ep = 16 * i + (x >> 2) * 8 + (y >> 2); }
        else { ep = (vcu >> 4) + i * (G >> 4); if (ep >= 352) return false; }
        const int e = ep / 22; u.pn = ep - e * 22; u.pm = batch_of() * NEXP + e; u.aux = e; return true;
    }
    DEVI const char* a_base(const Unit& u) const { return H + (size_t)(u.pm >> 4) * SEQ * DM; }
    DEVI const char* b_base(const Unit& u) const { return W1 + ((size_t)u.aux * 5632 + (size_t)u.pn * 256) * DM; }
    DEVI unsigned a_off(const Unit& u, int r, int cb) const { return (unsigned)((int)lidx[u.aux * CAP + r] * DM + cb); }
    DEVI int a_pitch() const { return DM; } DEVI int b_pitch() const { return 128; } DEVI size_t a_kstep() const { return 128; } DEVI size_t b_kstep() const { return 32768; }
};
struct SchedE2 {
    static constexpr bool GATHER = false;
    const char* ACT; const char* W2; int G, vcu;
    DEVI bool next(int i, Unit& u) const {
        const long L = (long)i * G + vcu; if (L >= 1024) return false;
        const int e = (int)(L >> 6), q = (int)(L & 63); u.pm = (q >> 2) * NEXP + e; u.pn = q & 3; u.aux = e; return true;
    }
    DEVI const char* a_base(const Unit& u) const { return ACT + (size_t)u.pm * CAP * DEXP; }
    DEVI const char* b_base(const Unit& u) const { return W2 + ((size_t)u.aux * DM + (size_t)u.pn * 256) * DEXP; }
    DEVI unsigned a_off(const Unit&, int r, int cb) const { return (unsigned)((cb >> 5) * 8192 + r * 32 + (cb & 31)); }
    DEVI int a_pitch() const { return 128; } DEVI int b_pitch() const { return 128; } DEVI size_t a_kstep() const { return 32768; } DEVI size_t b_kstep() const { return 32768; }
};

typedef f32x4 AccT[2][2][4][2];
DEVI u32x4 pack8(const f32x4 a, const f32x4 b) { u32x4 w; w.x = pk_h2(a[0], a[1]); w.y = pk_h2(a[2], a[3]); w.z = pk_h2(b[0], b[1]); w.w = pk_h2(b[2], b[3]); return w; }

struct EpiQKV {
    static constexpr bool HAS_MID = false;
    f16* proj; const float *g_naq, *g_nak, *g_gq, *g_gk;
    DEVI void mid(AccT&, const Unit&, int, int, int, int) const {}
    DEVI void operator()(const AccT& acc, const Unit& u, int wr, int wc, int fr, int fq) const {
        const int hs = u.pn * 4 + wc;
        const float* g = nullptr; bool rope = false; float sc = 1.f;
        if (hs < 8) { g = g_naq; sc = C2; } else if (hs < 16) { g = g_nak; } else if (hs < 24) { } else if (hs < 32) { g = g_gq; rope = true; sc = C2; } else if (hs < 34) { g = g_gk; rope = true; }
        f32x4 gv[2][2];
#pragma unroll
        for (int bj = 0; bj < 2; ++bj)
#pragma unroll
            for (int n = 0; n < 2; ++n) gv[bj][n] = g ? *(const f32x4*)(g + 32 * bj + 8 * fq + 4 * n) : (f32x4){1.f, 1.f, 1.f, 1.f};
#pragma unroll
        for (int ai = 0; ai < 2; ++ai)
#pragma unroll
            for (int m = 0; m < 4; ++m) {
                const int row = u.pm * BM + ai * HALF + wr * 64 + m * 16 + fr;
                f32x4 v[2][2];
#pragma unroll
                for (int bj = 0; bj < 2; ++bj)
#pragma unroll
                    for (int n = 0; n < 2; ++n) v[bj][n] = acc[ai][bj][m][n];
                if (g) {
                    float ssq = 0.f;
#pragma unroll
                    for (int bj = 0; bj < 2; ++bj)
#pragma unroll
                        for (int n = 0; n < 2; ++n) ssq += (v[bj][n][0] * v[bj][n][0] + v[bj][n][1] * v[bj][n][1]) + (v[bj][n][2] * v[bj][n][2] + v[bj][n][3] * v[bj][n][3]);
                    ssq += __shfl_xor(ssq, 16); ssq += __shfl_xor(ssq, 32);
                    const float rstd = rsqrtf(ssq * (1.f / 64.f) + EPS);
#pragma unroll
                    for (int bj = 0; bj < 2; ++bj)
#pragma unroll
                        for (int n = 0; n < 2; ++n) v[bj][n] = v[bj][n] * rstd * gv[bj][n];
                }
                if (rope) {
                    const int t = row & (SEQ - 1);
#pragma unroll
                    for (int bj = 0; bj < 2; ++bj) {
                        const int pos = bj ? (t & 63) : (t >> 6);
                        const f32x4 cc = *(const f32x4*)&g_rope.c[pos][4 * fq], ss = *(const f32x4*)&g_rope.s[pos][4 * fq];
#pragma unroll
                        for (int n = 0; n < 2; ++n) {
                            const float x0 = v[bj][n][0], x1 = v[bj][n][1], x2 = v[bj][n][2], x3 = v[bj][n][3];
                            v[bj][n][0] = x0 * cc[2 * n] - x1 * ss[2 * n]; v[bj][n][1] = x0 * ss[2 * n] + x1 * cc[2 * n];
                            v[bj][n][2] = x2 * cc[2 * n + 1] - x3 * ss[2 * n + 1]; v[bj][n][3] = x2 * ss[2 * n + 1] + x3 * cc[2 * n + 1];
                        }
                    }
                }
                {
                    const u32x4 d0 = pack8(v[0][0] * sc, v[0][1] * sc), d1 = pack8(v[1][0] * sc, v[1][1] * sc);
                    const bool lowr = fr < 8; u32x4 rcv, s1, s2;
#pragma unroll
                    for (int i = 0; i < 4; ++i) { const unsigned snd = lowr ? d1[i] : d0[i]; rcv[i] = (unsigned)__builtin_amdgcn_update_dpp(0, (int)snd, 0x128, 0xF, 0xF, true); s1[i] = lowr ? d0[i] : rcv[i]; s2[i] = lowr ? rcv[i] : d1[i]; }
                    f16* c0 = proj + (size_t)(row - fr + (fr & 7)) * INW + hs * 64 + 8 * fq + 32 * (fr >> 3);
                    *(u32x4*)c0 = s1; *(u32x4*)(c0 + (size_t)8 * INW) = s2;
                }
            }
    }
};
struct EpiOut {
    static constexpr bool HAS_MID = true;
    const f16* xn; const float* rms1; f16* h16; LAS f32x2* rab; const float* ssq; unsigned char* h8;
    const f16* wrt; float* part; float* ssq2p; unsigned* pcnt; float* aff; float* rstd2; volatile LAS unsigned* flag;
    DEVI void mid(AccT& acc, const Unit& u, int wr, int wc, int fr, int fq) const {
        LAS float* mine = (LAS float*)rab + (wr * 4 + wc) * 128;
        int lofs = (fq * 4) * MTOK + fr; asm volatile("" : "+v"(lofs));
        const float* sp0 = ssq + (size_t)u.pm * BM + wr * 64 + lofs;
#pragma unroll
        for (int g = 0; g < 8; ++g) { const int ai = g >> 2, m = g & 3;
            const float* sp = sp0 + ai * HALF + m * 16;
            float t = (sp[0] + sp[(size_t)MTOK]) + (sp[(size_t)2 * MTOK] + sp[(size_t)3 * MTOK]);
            { auto r_ = __builtin_amdgcn_permlane16_swap(__float_as_uint(t), __float_as_uint(t), false, false); t = __uint_as_float(r_[0]) + __uint_as_float(r_[1]); }
            auto r2 = __builtin_amdgcn_permlane32_swap(__float_as_uint(t), __float_as_uint(t), false, false);
            const float o_ = (fq < 2) ? __uint_as_float(r2[1]) : __uint_as_float(r2[0]);
            const float sa = (fq < 2) ? t : o_, sb = (fq < 2) ? o_ : t;
            const float ra = rsqrtf(sa * (1.f / 512.f) + EPS), rb = rsqrtf(sb * (1.f / 512.f) + EPS), ratio = ra / rb;
            if (fq == 0) mine[g * 16 + fr] = rb;
#pragma unroll
            for (int bj = 0; bj < 2; ++bj)
#pragma unroll
                for (int n = 0; n < 2; ++n) acc[ai][bj][m][n] = acc[ai][bj][m][n] * ratio;
            if (g & 1) SCHED0;
        }
    }
    DEVI void finalize(int pm, int tid) const {
        asm volatile("" : "+v"(tid));
        const int row = pm * BM + (tid >> 1), hf = tid & 1;
        f32x4 l0 = {0.f, 0.f, 0.f, 0.f}, l1 = l0, l2 = l0, l3 = l0; float sq = 0.f;
#pragma unroll
        for (int s8 = 0; s8 < 8; ++s8) { const int sl = hf * 8 + s8; const f32x4* p = (const f32x4*)(part + ((size_t)sl * MTOK + (row & ~15) + ((row & 3) << 2) + ((row >> 2) & 3)) * 16);
            l0 += p[0]; l1 += p[1]; l2 += p[2]; l3 += p[3]; sq += ssq2p[(size_t)sl * MTOK + row]; }
        float lg[16] = {l0[0], l0[1], l0[2], l0[3], l1[0], l1[1], l1[2], l1[3], l2[0], l2[1], l2[2], l2[3], l3[0], l3[1], l3[2], l3[3]};
        float other = __builtin_bit_cast(float, __builtin_amdgcn_update_dpp(0, __builtin_bit_cast(int, sq), 0xB1, 0xF, 0xF, true));
        sq = hf ? (other + sq) : (sq + other);
        const float rs = rsqrtf(sq * (1.f / DM) + EPS);
        float mx = -1e30f;
#pragma unroll
        for (int e = 0; e < 16; ++e) { const float o2 = __builtin_bit_cast(float, __builtin_amdgcn_update_dpp(0, __builtin_bit_cast(int, lg[e]), 0xB1, 0xF, 0xF, true));
            lg[e] = (hf ? (o2 + lg[e]) : (lg[e] + o2)) * rs; mx = fmaxf(mx, lg[e]); }
        float sum = 0.f;
#pragma unroll
        for (int e = 0; e < 16; ++e) { lg[e] = __expf(lg[e] - mx); sum += lg[e]; }
        const float inv = 1.f / sum; const int b = row >> 11, tt = row & (SEQ - 1);
#pragma unroll
        for (int e = 0; e < 16; ++e) if ((e >> 3) == hf) aff[((size_t)b * NEXP + e) * SEQ + tt] = lg[e] * inv;
        if (hf == 0) rstd2[row] = rs;
    }
    struct RowIn { u32x4 a, b; float rm; };
    DEVI void load_rg(RowIn& R, const Unit& u, int g, int wr, int wc, int fr, int fq) const {
        const int row = u.pm * BM + (g >> 2) * HALF + wr * 64 + (g & 3) * 16 + fr;
        const size_t off = (size_t)row * DM + u.pn * BM + wc * 64 + 8 * fq;
        R.a = *(const u32x4*)(xn + off); R.b = *(const u32x4*)(xn + off + 32); R.rm = rms1[row];
    }
    static DEVI void xres(const u32x4 w, float rm, f32x4& x0, f32x4& x1) { const f16x8 h = __builtin_bit_cast(f16x8, w);
        x0 = (f32x4){(float)h[0], (float)h[1], (float)h[2], (float)h[3]} * rm; x1 = (f32x4){(float)h[4], (float)h[5], (float)h[6], (float)h[7]} * rm; }
    DEVI void operator()(const AccT& acc, const Unit& u, int wr, int wc, int fr, int fq) const {
        const int slice = u.pn * 4 + wc;
        const f16* wb = wrt + (size_t)fr * DM + u.pn * BM + wc * 64 + 8 * fq;
        const f16x8 bh0 = *(const f16x8*)(wb), bh1 = *(const f16x8*)(wb + 32), bl0 = *(const f16x8*)(wb + (size_t)NEXP * DM), bl1 = *(const f16x8*)(wb + (size_t)NEXP * DM + 32);
        RowIn Ra, Rb, Rc, Rd;
        load_rg(Ra, u, 0, wr, wc, fr, fq); load_rg(Rb, u, 1, wr, wc, fr, fq); load_rg(Rc, u, 2, wr, wc, fr, fq);
#define EO_GROUP(g, R) do { const int ai = (g) >> 2, m = (g) & 3; \
            const int row16 = u.pm * BM + ai * HALF + wr * 64 + m * 16, row = row16 + fr; \
            const float rb = ((const LAS float*)rab)[(wr * 4 + wc) * 128 + (g) * 16 + fr]; \
            const size_t off = (size_t)row * DM + u.pn * BM + wc * 64 + 8 * fq; \
            f32x4 lg = {0.f, 0.f, 0.f, 0.f}; float sq = 0.f; u32x4 hi8s_[2]; \
            _Pragma("unroll") for (int bj = 0; bj < 2; ++bj) { \
                f32x4 xr0_, xr1_; xres(bj ? R.b : R.a, R.rm, xr0_, xr1_); \
                const f32x4 h0 = xr0_ + acc[ai][bj][m][0] * rb, h1 = xr1_ + acc[ai][bj][m][1] * rb; \
                const u32x4 hi8 = pack8(h0, h1); \
                hi8s_[bj] = hi8; \
                { u32x2 q; q.x = pk_f8x4(h0[0] * H_SCALE, h0[1] * H_SCALE, h0[2] * H_SCALE, h0[3] * H_SCALE); q.y = pk_f8x4(h1[0] * H_SCALE, h1[1] * H_SCALE, h1[2] * H_SCALE, h1[3] * H_SCALE); *(u32x2*)(h8 + off + 32 * bj) = q; } \
                const f16x8 hh = __builtin_bit_cast(f16x8, hi8); \
                const f32x4 d0 = {h0[0] - (float)hh[0], h0[1] - (float)hh[1], h0[2] - (float)hh[2], h0[3] - (float)hh[3]}, d1 = {h1[0] - (float)hh[4], h1[1] - (float)hh[5], h1[2] - (float)hh[6], h1[3] - (float)hh[7]}; \
                const f16x8 hl = __builtin_bit_cast(f16x8, pack8(d0, d1)); \
                lg = __builtin_amdgcn_mfma_f32_16x16x32_f16(hh, bj ? bh1 : bh0, lg, 0, 0, 0); \
                lg = __builtin_amdgcn_mfma_f32_16x16x32_f16(hh, bj ? bl1 : bl0, lg, 0, 0, 0); \
                lg = __builtin_amdgcn_mfma_f32_16x16x32_f16(hl, bj ? bh1 : bh0, lg, 0, 0, 0); \
                sq += ((h0[0] * h0[0] + h0[1] * h0[1]) + (h0[2] * h0[2] + h0[3] * h0[3])) + ((h1[0] * h1[0] + h1[1] * h1[1]) + (h1[2] * h1[2] + h1[3] * h1[3])); } \
            { const bool lowr_ = fr < 8; u32x4 rcv_, s1_, s2_;     \
              _Pragma("unroll") for (int i = 0; i < 4; ++i) { const unsigned snd_ = lowr_ ? hi8s_[1][i] : hi8s_[0][i]; rcv_[i] = (unsigned)__builtin_amdgcn_update_dpp(0, (int)snd_, 0x128, 0xF, 0xF, true); s1_[i] = lowr_ ? hi8s_[0][i] : rcv_[i]; s2_[i] = lowr_ ? rcv_[i] : hi8s_[1][i]; } \
              f16* c0_ = h16 + (size_t)(row16 + (fr & 7)) * DM + u.pn * BM + wc * 64 + 8 * fq + 32 * (fr >> 3); \
              *(u32x4*)c0_ = s1_; *(u32x4*)(c0_ + (size_t)8 * DM) = s2_; } \
            { auto r_ = __builtin_amdgcn_permlane16_swap(__float_as_uint(sq), __float_as_uint(sq), false, false); sq = __uint_as_float(r_[0]) + __uint_as_float(r_[1]); } \
            { auto r_ = __builtin_amdgcn_permlane32_swap(__float_as_uint(sq), __float_as_uint(sq), false, false); sq = __uint_as_float(r_[0]) + __uint_as_float(r_[1]); } \
            if (fq == 0) __hip_atomic_store(ssq2p + (size_t)slice * MTOK + row, sq, __ATOMIC_RELAXED, __HIP_MEMORY_SCOPE_AGENT);     \
            float* pp = part + ((size_t)slice * MTOK + row16 + fq) * 16 + fr;         \
            _Pragma("unroll") for (int r = 0; r < 4; ++r) __hip_atomic_store(pp + r * 64, lg[r], __ATOMIC_RELAXED, __HIP_MEMORY_SCOPE_AGENT); } while (0)
        load_rg(Rd, u, 3, wr, wc, fr, fq); SCHED0; EO_GROUP(0, Ra); SCHED0;
        load_rg(Ra, u, 4, wr, wc, fr, fq); SCHED0; EO_GROUP(1, Rb); SCHED0;
        load_rg(Rb, u, 5, wr, wc, fr, fq); SCHED0; EO_GROUP(2, Rc); SCHED0;
        load_rg(Rc, u, 6, wr, wc, fr, fq); SCHED0; EO_GROUP(3, Rd); SCHED0;
        load_rg(Rd, u, 7, wr, wc, fr, fq); SCHED0; EO_GROUP(4, Ra); SCHED0;
        EO_GROUP(5, Rb); SCHED0;
        EO_GROUP(6, Rc); SCHED0;
        EO_GROUP(7, Rd); SCHED0;
#undef EO_GROUP
        const int lane = fr + 16 * fq; const bool leader = (wr == 0 && wc == 0 && lane == 0);
        asm volatile("s_waitcnt vmcnt(0)" ::: "memory");
        __syncthreads();
        if (leader) {
            const unsigned old = __hip_atomic_fetch_add(pcnt + 64 * u.pm, 1u, __ATOMIC_RELAXED, __HIP_MEMORY_SCOPE_AGENT);
            const unsigned last = (old == 3u) ? 1u : 0u;
            if (last) { __builtin_amdgcn_fence(__ATOMIC_ACQUIRE, "agent"); asm volatile("s_waitcnt vmcnt(0)" ::: "memory"); }
            flag[2] = last;
        }
        __syncthreads();
        if (flag[2]) finalize(u.pm, (wr * 4 + wc) * 64 + lane);
        __syncthreads();
    }
};
struct EpiAct {
    static constexpr bool HAS_MID = false;
    unsigned char* act; const LAS float* lrss;
    DEVI void mid(AccT&, const Unit&, int, int, int, int) const {}
    DEVI void operator()(const AccT& acc, const Unit& u, int wr, int wc, int fr, int fq) const {
#pragma unroll
        for (int ai = 0; ai < 2; ++ai)
#pragma unroll
            for (int m = 0; m < 4; ++m) {
                const size_t prow = (size_t)u.pm * CAP + ai * HALF + wr * 64 + m * 16 + fr;
                const float rs = lrss[u.aux * CAP + ai * HALF + wr * 64 + m * 16 + fr] * (1.f / (H_SCALE * W_SCALE));
                f32x4 a[2];
                const f32x2 rs2 = {rs, rs}, rsn = {rs * -LOG2E, rs * -LOG2E}, rsa = {rs * A_SCALE, rs * A_SCALE}, one2 = {1.f, 1.f};
#pragma unroll
                for (int n = 0; n < 2; ++n)
#pragma unroll
                    for (int i = 0; i < 4; i += 2) {
                        const f32x2 ag = {acc[ai][0][m][n][i], acc[ai][0][m][n][i + 1]}, au = {acc[ai][1][m][n][i], acc[ai][1][m][n][i + 1]};
                        const f32x2 t = ag * rsn; f32x2 d = {__builtin_amdgcn_exp2f(t[0]), __builtin_amdgcn_exp2f(t[1])}; d = d + one2;
                        const f32x2 r = {__builtin_amdgcn_rcpf(d[0]), __builtin_amdgcn_rcpf(d[1])};
                        const f32x2 o = ((ag * rs2) * r) * (au * rsa);
                        a[n][i] = o[0]; a[n][i + 1] = o[1]; }
                u32x2 q; q.x = pk_f8x4(a[0][0], a[0][1], a[0][2], a[0][3]); q.y = pk_f8x4(a[1][0], a[1][1], a[1][2], a[1][3]);
                __builtin_nontemporal_store(q, (u32x2*)(act + ((size_t)u.pm * 22 + u.pn) * 32768 + (size_t)wc * 8192 + (size_t)(ai * HALF + wr * 64 + m * 16 + fr) * 32 + 8 * fq));
            }
    }
};
struct EpiY {
    static constexpr bool HAS_MID = false;
    f16* y; const float* gate;
    DEVI void mid(AccT&, const Unit&, int, int, int, int) const {}
    DEVI void operator()(const AccT& acc, const Unit& u, int wr, int wc, int fr, int fq) const {
        float gts[2][4];
#pragma unroll
        for (int ai = 0; ai < 2; ++ai)
#pragma unroll
            for (int m = 0; m < 4; ++m) gts[ai][m] = gate[(size_t)u.pm * CAP + ai * HALF + wr * 64 + m * 16 + fr];
        asm volatile("s_waitcnt vmcnt(0)" ::: "memory");
        const bool lowr = fr < 8; const int r8 = fr & 7, hb = fr >> 3;
#pragma unroll
        for (int ai = 0; ai < 2; ++ai)
#pragma unroll
            for (int m = 0; m < 4; ++m) {
                const float gt = gts[ai][m] * (Y_SCALE / (A_SCALE * W_SCALE));
                u32x2 d0, d1;
                { const f32x4 a0 = acc[ai][0][m][0] * gt, a1 = acc[ai][0][m][1] * gt, b0 = acc[ai][1][m][0] * gt, b1 = acc[ai][1][m][1] * gt;
                  d0.x = pk_f8x4(a0[0], a0[1], a0[2], a0[3]); d0.y = pk_f8x4(a1[0], a1[1], a1[2], a1[3]); d1.x = pk_f8x4(b0[0], b0[1], b0[2], b0[3]); d1.y = pk_f8x4(b1[0], b1[1], b1[2], b1[3]); }
                u32x2 rcv, s1, s2;
#pragma unroll
                for (int i = 0; i < 2; ++i) { const unsigned snd = lowr ? d1[i] : d0[i]; rcv[i] = (unsigned)__builtin_amdgcn_update_dpp(0, (int)snd, 0x128, 0xF, 0xF, true); s1[i] = lowr ? d0[i] : rcv[i]; s2[i] = lowr ? rcv[i] : d1[i]; }
                const size_t prow0 = (size_t)u.pm * CAP + ai * HALF + wr * 64 + m * 16;
                unsigned char* c0 = (unsigned char*)y + u.pn * BM + wc * 64 + 8 * fq + 32 * hb;
                __builtin_nontemporal_store(s1, (u32x2*)(c0 + (prow0 + r8) * DM));
                __builtin_nontemporal_store(s2, (u32x2*)(c0 + (prow0 + 8 + r8) * DM));
            }
    }
};
}

namespace attn_body {
using s16x4 = __attribute__((ext_vector_type(4))) short;
using s16x8 = __attribute__((ext_vector_type(8))) short;
using f32x16 = __attribute__((ext_vector_type(16))) float;
constexpr int NW = 8, QBLK = 32, QB = QBLK * NW, KVBLK = 64, PITCH = INW;
constexpr int NSLOT = 3, SLOTB = 8192;
constexpr int LDS_K = 0, LDS_V = NSLOT * SLOTB, LDS_WS = 2 * NSLOT * SLOTB, LDS_OST = LDS_WS + NW * 64 * 4, LDS_BIAS = LDS_OST + NW * 4096, LDS_BYTES = LDS_BIAS + 640 * 4;
constexpr int BIAS_PAD = 64;
constexpr float NEGBIG = -1000.f;
DEVI int crow(int r, int hi) { return (r & 3) + 8 * (r >> 2) + 4 * hi; }
#define ASBAR() __builtin_amdgcn_sched_barrier(0)
DEVI void glds16s(const void* sbase, unsigned voff, unsigned lds_dst) { unsigned keep;
    asm volatile("s_mov_b32 %0, m0\n\ts_mov_b32 m0, %3\n\ts_nop 0\n\tglobal_load_lds_dwordx4 %1, %2\n\ts_mov_b32 m0, %0" : "=&s"(keep) : "v"(voff), "s"(sbase), "s"(lds_dst) : "memory"); }
DEVI float max3f(float a, float b, float c) { float r; asm("v_max3_f32 %0, %1, %2, %3" : "=v"(r) : "v"(a), "v"(b), "v"(c)); return r; }
DEVI float max2f(float a, float b) { float r; asm("v_max_f32_e32 %0, %1, %2" : "=v"(r) : "v"(a), "v"(b)); return r; }
DEVI float fadd_s(float a, float b) { float r; asm("v_add_f32_e32 %0, %1, %2" : "=v"(r) : "v"(a), "v"(b)); return r; }
DEVI float fsub_s(float a, float b) { float r; asm("v_sub_f32_e32 %0, %1, %2" : "=v"(r) : "v"(a), "v"(b)); return r; }
DEVI unsigned cvtpk_s(float lo, float hi) { return pk_h2(lo, hi); }
#define WAIT_BAR(N) asm volatile("s_waitcnt vmcnt(" #N ") lgkmcnt(0)\n\ts_barrier" ::: "memory")
#define MFMA32(a, b, c) __builtin_amdgcn_mfma_f32_32x32x16_f16(a, b, c, 0, 0, 0)
typedef LAS const char* lds_cptr;
typedef short v4i16_t __attribute__((ext_vector_type(4)));

DEVI void qkt(f32x16& p0, f32x16& p1, const char* Kslot, const f16x8* qr, const f32x16& negm, int r32, int hi) {
    const char* kb = Kslot + hi * 1024 + r32 * 16;
#pragma unroll
    for (int d0 = 0; d0 < 4; ++d0) {
        const f16x8 b0 = *reinterpret_cast<const f16x8*>(kb + d0 * 2048);
        const f16x8 b1 = *reinterpret_cast<const f16x8*>(kb + d0 * 2048 + 512);
        if (d0 == 0) { p0 = MFMA32(b0, qr[0], negm); p1 = MFMA32(b1, qr[0], negm); }
        else { p0 = MFMA32(b0, qr[d0], p0); p1 = MFMA32(b1, qr[d0], p1); } }
}
DEVI void kload8(f16x8* kf, lds_cptr kp) {
    kf[0] = *(const LAS f16x8*)(kp);        kf[1] = *(const LAS f16x8*)(kp + 512);
    kf[2] = *(const LAS f16x8*)(kp + 2048); kf[3] = *(const LAS f16x8*)(kp + 2560);
    kf[4] = *(const LAS f16x8*)(kp + 4096); kf[5] = *(const LAS f16x8*)(kp + 4608);
    kf[6] = *(const LAS f16x8*)(kp + 6144); kf[7] = *(const LAS f16x8*)(kp + 6656);
}
DEVI void kload2(f16x8* kf, lds_cptr kp, int j) { kf[2 * j] = *(const LAS f16x8*)(kp + j * 2048); kf[2 * j + 1] = *(const LAS f16x8*)(kp + j * 2048 + 512); }
DEVI s16x4 vtr(lds_cptr p) { return __builtin_bit_cast(s16x4, __builtin_amdgcn_ds_read_tr16_b64_v4i16((LAS v4i16_t*)p)); }
DEVI float rowmax(const f32x16& p0, const f32x16& p1) {
    float a = max3f(p0[0], p0[1], p1[0]), b = max3f(p0[2], p0[3], p1[1]); a = max3f(a, p1[2], p1[3]);
#pragma unroll
    for (int r = 4; r < 16; r += 4) { a = max3f(a, p0[r], p0[r + 1]); b = max3f(b, p0[r + 2], p0[r + 3]); a = max3f(a, p1[r], p1[r + 1]); b = max3f(b, p1[r + 2], p1[r + 3]); }
    const float m = max2f(a, b);
    auto rr = __builtin_amdgcn_permlane32_swap(__float_as_uint(m), __float_as_uint(m), false, false);
    return max2f(__uint_as_float(rr[0]), __uint_as_float(rr[1]));
}
DEVI void pv(f32x16* o, int vb, f16x8 pa0, f16x8 pa1, f16x8 pa2, f16x8 pa3) {
#pragma unroll
    for (int d0 = 0; d0 < 2; ++d0) { s16x4 lo[4], hi[4];
#pragma unroll
        for (int ks = 0; ks < 4; ++ks) {
            asm volatile("ds_read_b64_tr_b16 %0,%1 offset:%c2" : "=&v"(lo[ks]) : "v"(vb), "i"(d0 * 4096 + ks * 1024) : "memory");
            asm volatile("ds_read_b64_tr_b16 %0,%1 offset:%c2" : "=&v"(hi[ks]) : "v"(vb), "i"(d0 * 4096 + ks * 1024 + 512) : "memory"); }
        asm volatile("s_waitcnt lgkmcnt(0)" ::: "memory"); ASBAR();
#define PK(k) __builtin_bit_cast(f16x8, (s16x8){lo[k][0], lo[k][1], lo[k][2], lo[k][3], hi[k][0], hi[k][1], hi[k][2], hi[k][3]})
        o[d0] = MFMA32(pa0, PK(0), o[d0]);
        o[d0] = MFMA32(pa1, PK(1), o[d0]);
        o[d0] = MFMA32(pa2, PK(2), o[d0]);
        o[d0] = MFMA32(pa3, PK(3), o[d0]);
#undef PK
    }
}

struct AttnU {
    const f16* Qp;
    const f16* Kp;
    const f16* Vp;
    f16* Op;
    float* ssq;
    int NT;
    int r0, kr0;
    const float* rpb_h;
};

template <int THRL, int MODE> DEVI void attn_unit(const AttnU& U, const f16* nQ, const f16* nK, const f16* nV, const bool primed, f16x8 (&qr)[4], char* shm, const int wid) {
    const int lane = lane_id_v(), tid = wid * 64 + lane, r32 = lane & 31, hi = lane >> 5;
    const f16* Qw = U.Qp + (size_t)(wid * QBLK) * PITCH;
    const unsigned lds0 = (unsigned)(uintptr_t)shm;
    float* wsf = (float*)(shm + LDS_WS) + wid * 64;
    const unsigned koff = (unsigned)(lane * PITCH + wid * 8) * 2u;
    const unsigned voff = (unsigned)((16 * (wid & 3) + (lane >> 2)) * PITCH + (wid >> 2) * 32 + (lane & 3) * 8) * 2u;
    const unsigned kdst = lds0 + LDS_K + wid * 1024, vdst = lds0 + LDS_V + wid * 1024;
#define DMA_K(t, slot) glds16s(U.Kp + (size_t)(t) * KVBLK * PITCH, koff, (unsigned)__builtin_amdgcn_readfirstlane(kdst + (slot)))
#define DMA_V(t, slot) glds16s(U.Vp + (size_t)(t) * KVBLK * PITCH, voff, (unsigned)__builtin_amdgcn_readfirstlane(vdst + (slot)))
    const char* Kbase = shm + LDS_K; f16x8 kf[8];
    const lds_cptr shm3 = (lds_cptr)shm; const lds_cptr kp0 = shm3 + LDS_K + hi * 1024 + r32 * 16; const lds_cptr vp0 = shm3 + LDS_V + ((lane >> 4) & 1) * 32 + (lane & 3) * 8 + (4 * hi + ((lane & 15) >> 2)) * 64;
    const int NT = U.NT;
    if (!primed) {
        DMA_K(0, 0); DMA_V(0, 0); DMA_K(1, SLOTB);
#pragma unroll
        for (int d0 = 0; d0 < 4; ++d0) qr[d0] = *reinterpret_cast<const f16x8*>(&Qw[(size_t)r32 * PITCH + d0 * 16 + hi * 8]);
    }
    const LAS float* btab = (const LAS float*)(shm3 + LDS_BIAS);
    int na_lo = 0, na_lb0 = 0, na_rs = 0, na_qr = 0;
    if (MODE == 1) {
        LAS float* bw = (LAS float*)(shm3 + LDS_BIAS);
        for (int i = tid; i < 465; i += 512) bw[BIAS_PAD + i] = U.rpb_h[i] * LOG2E;
        na_qr = U.r0 + (wid >> 1); const int qc = 32 * (wid & 1) + r32;
        int cs = qc - 8; cs = cs < 0 ? 0 : (cs > GRIDW - 16 ? GRIDW - 16 : cs);
        na_rs = na_qr - 4; na_rs = na_rs < 0 ? 0 : (na_rs > GROWS - 8 ? GROWS - 8 : na_rs);
        na_lo = 4 * hi - cs;
        na_lb0 = BIAS_PAD + 15 - qc + 4 * hi;
    }
    float mhat = 0.f, l_reg = 0.f; f32x16 o[2]; o[0] = f32x16{}; o[1] = f32x16{}; f32x16 negm = f32x16{}; if (MODE == 0) asm volatile("" : "+v"(negm));
#define NEGM (MODE == 0 ? negm : f32x16{})
#define HOOK(P0, P1, t) do { if (MODE == 1) { const int kr_ = U.kr0 + (t); const bool rowok_ = (kr_ >= na_rs) && (kr_ < na_rs + 8); \
        if (rowok_) { const LAS float* bp_ = btab + ((kr_ - na_qr + 7) * 31 + na_lb0); const float nm_ = -mhat; \
            _Pragma("unroll") for (int r = 0; r < 16; ++r) { const int c0_ = (r & 3) + 8 * (r >> 2); \
                P0[r] = ((unsigned)(c0_ + na_lo) < 16u) ? (P0[r] + bp_[c0_]) + nm_ : NEGBIG; P1[r] = ((unsigned)(c0_ + 32 + na_lo) < 16u) ? (P1[r] + bp_[c0_ + 32]) + nm_ : NEGBIG; } } \
        else { _Pragma("unroll") for (int r = 0; r < 16; ++r) { P0[r] = NEGBIG; P1[r] = NEGBIG; } } } } while (0)
    bool resc = false;
#define START(P0, P1) do { const float rm = rowmax(P0, P1); resc = false; \
    { const float dl = rm; mhat = fadd_s(mhat, dl); \
      _Pragma("unroll") for (int r = 0; r < 16; ++r) { P0[r] = fsub_s(P0[r], dl); P1[r] = fsub_s(P1[r], dl); } \
      if (MODE == 0) { _Pragma("unroll") for (int r = 0; r < 16; ++r) negm[r] = -mhat; asm volatile("" : "+v"(negm)); } } \
    _Pragma("unroll") for (int r = 0; r < 16; ++r) P0[r] = __builtin_amdgcn_exp2f(P0[r]); } while (0)
#define RESC() do { if (resc) { asm volatile("s_waitcnt lgkmcnt(0)" ::: "memory"); \
      _Pragma("unroll") for (int d_ = 0; d_ < 2; ++d_) _Pragma("unroll") for (int r = 0; r < 16; ++r) o[d_][r] *= wsf[crow(r, hi)]; } } while (0)
    f32x16 pA0, pA1, pB0, pB1;
    int sl_prev = 0, sl_cur = 0, sl_next = SLOTB;
#define ROT() do { sl_prev = sl_cur; sl_cur = sl_next; sl_next = (sl_next == (NSLOT - 1) * SLOTB) ? 0 : sl_next + SLOTB; } while (0)
    DMA_K(2, 2 * SLOTB);
    WAIT_BAR(3);
    qkt(pA0, pA1, Kbase, qr, NEGM, r32, hi); asm volatile("s_nop 15\n\ts_nop 7" : "+v"(pA0), "+v"(pA1)); HOOK(pA0, pA1, 0);
    START(pA0, pA1);
#pragma unroll
    for (int r = 0; r < 16; ++r) pA1[r] = __builtin_amdgcn_exp2f(pA1[r]);
    WAIT_BAR(0);
    DMA_K(3, 0); DMA_V(1, SLOTB);
    ROT();
    kload8(kf, kp0 + sl_cur);
    WAIT_BAR(2);
    s16x4 vlo[8], vhi[8]; u32x4 pw0, pw1, pw2, pw3;
#define PKW(P, B) cvtpk_s(P[B], P[B + 1])
#define PAF(k) __builtin_bit_cast(f16x8, pw##k)
#define VFR(i) __builtin_bit_cast(f16x8, (s16x8){vlo[i][0], vlo[i][1], vlo[i][2], vlo[i][3], vhi[i][0], vhi[i][1], vhi[i][2], vhi[i][3]})
#define PIN(x) asm volatile("" : "+v"(x))
#define MX3(a, b, c) __builtin_fmaxf(__builtin_fmaxf((a), (b)), (c))
#define GAPA(MF, A0, A1, A2, A3, W0, W1, PW) do { MF; sacc += A0; sacc += A1; sacc += A2; sacc += A3; PIN(sacc); W0; W1; PIN(PW); ASBAR(); } while (0)
#define EX(v) __builtin_amdgcn_exp2f(v)
#define GAPB(MF, X, B) do { MF; X[B] = EX(X[B]); X[B + 1] = EX(X[B + 1]); X[B + 2] = EX(X[B + 2]); X[B + 3] = EX(X[B + 3]); PIN(X); ASBAR(); } while (0)
#define VRD(i) do { vlo[i] = vtr(vp_ + (((i) >> 2) * 4096 + ((i) & 3) * 1024)); vhi[i] = vtr(vp_ + (((i) >> 2) * 4096 + ((i) & 3) * 1024 + 512)); } while (0)
#define KRD(G, j) do { if (G) { kload2(kf, kp0 + sl_next, j); ASBAR(); } } while (0)
#define STEP(C0, C1, P0, P1, t, GK, GV, GL) do { ASBAR(); \
    const lds_cptr vp_ = vp0 + sl_prev; \
    VRD(0); ASBAR(); float sacc = (P0[0] + P0[1]); \
    GAPA(C0 = MFMA32(kf[0], qr[0], NEGM), P0[2], P0[3], P0[4], P0[5],     pw0[0] = PKW(P0, 0), pw0[1] = PKW(P0, 2), pw0); \
    VRD(4); ASBAR(); GAPA(C1 = MFMA32(kf[1], qr[0], NEGM), P0[6], P0[7], P0[8], P0[9],     pw0[2] = PKW(P0, 4), pw0[3] = PKW(P0, 6), pw0); \
    VRD(1); ASBAR(); GAPA(C0 = MFMA32(kf[2], qr[1], C0),   P0[10], P0[11], P0[12], P0[13], pw1[0] = PKW(P0, 8), pw1[1] = PKW(P0, 10), pw1); \
    VRD(5); ASBAR(); GAPA(C1 = MFMA32(kf[3], qr[1], C1),   P0[14], P0[15], P1[0], P1[1],   pw1[2] = PKW(P0, 12), pw1[3] = PKW(P0, 14), pw1); \
    VRD(2); ASBAR(); GAPA(C0 = MFMA32(kf[4], qr[2], C0),   P1[2], P1[3], P1[4], P1[5],     pw2[0] = PKW(P1, 0), pw2[1] = PKW(P1, 2), pw2); \
    VRD(6); ASBAR(); GAPA(C1 = MFMA32(kf[5], qr[2], C1),   P1[6], P1[7], P1[8], P1[9],     pw2[2] = PKW(P1, 4), pw2[3] = PKW(P1, 6), pw2); \
    VRD(3); ASBAR(); GAPA(C0 = MFMA32(kf[6], qr[3], C0),   P1[10], P1[11], P1[12], P1[13], pw3[0] = PKW(P1, 8), pw3[1] = PKW(P1, 10), pw3); \
    VRD(7); ASBAR(); GAPA(C1 = MFMA32(kf[7], qr[3], C1),   P1[14], P1[15], 0.f, 0.f,       pw3[2] = PKW(P1, 12), pw3[3] = PKW(P1, 14), pw3); \
    l_reg += sacc; \
    if (GK) { DMA_K((t) + 3, sl_cur); } if (GV) { DMA_V((t) + 1, sl_next); } \
    HOOK(C0, C1, t); \
    { float a = MX3(C0[0], C0[1], C1[0]), b = MX3(C0[2], C0[3], C1[1]); a = MX3(a, C1[2], C1[3]); \
      _Pragma("unroll") for (int r = 4; r < 16; r += 4) { a = MX3(a, C0[r], C0[r + 1]); b = MX3(b, C0[r + 2], C0[r + 3]); a = MX3(a, C1[r], C1[r + 1]); b = MX3(b, C1[r + 2], C1[r + 3]); } \
      float rm = __builtin_fmaxf(a, b); { auto rr = __builtin_amdgcn_permlane32_swap(__float_as_uint(rm), __float_as_uint(rm), false, false); rm = __builtin_fmaxf(__uint_as_float(rr[0]), __uint_as_float(rr[1])); } \
      resc = false; \
      if (__builtin_expect(__any(rm > (float)THRL), 0)) { const float dl = __builtin_fmaxf(rm, 0.f); mhat += dl; \
        _Pragma("unroll") for (int r = 0; r < 16; ++r) { C0[r] -= dl; C1[r] -= dl; } \
        if (MODE == 0) { _Pragma("unroll") for (int r = 0; r < 16; ++r) negm[r] = -mhat; asm volatile("" : "+v"(negm)); } \
        const float f = __builtin_amdgcn_exp2f(-dl); l_reg *= f; if (hi == 0) wsf[r32] = f; resc = true; } } \
    ASBAR(); \
    GAPB(o[0] = MFMA32(PAF(0), VFR(0), o[0]), C0, 0); \
    GAPB(o[1] = MFMA32(PAF(0), VFR(4), o[1]), C0, 4); \
    KRD(GL, 0); GAPB(o[0] = MFMA32(PAF(1), VFR(1), o[0]), C0, 8); \
    KRD(GL, 1); GAPB(o[1] = MFMA32(PAF(1), VFR(5), o[1]), C0, 12); \
    KRD(GL, 2); GAPB(o[0] = MFMA32(PAF(2), VFR(2), o[0]), C1, 0); \
    KRD(GL, 3); GAPB(o[1] = MFMA32(PAF(2), VFR(6), o[1]), C1, 4); \
    GAPB(o[0] = MFMA32(PAF(3), VFR(3), o[0]), C1, 8); \
    GAPB(o[1] = MFMA32(PAF(3), VFR(7), o[1]), C1, 12); \
    } while (0)
    int t = 1;
    for (; t + 5 < NT; t += 2) {
        STEP(pB0, pB1, pA0, pA1, t, true, true, true);       WAIT_BAR(2); RESC(); ROT();
        STEP(pA0, pA1, pB0, pB1, t + 1, true, true, true);   WAIT_BAR(2); RESC(); ROT();
    }
#define ENDW(tt) do { if ((tt) + 3 < NT) { WAIT_BAR(2); } else if ((tt) + 2 < NT) { WAIT_BAR(1); } else { WAIT_BAR(0); } } while (0)
    for (; t + 1 < NT; t += 2) {
        STEP(pB0, pB1, pA0, pA1, t, (t + 3 < NT), (t + 1 < NT), (t + 1 < NT));         ENDW(t);     RESC(); ROT();
        STEP(pA0, pA1, pB0, pB1, t + 1, (t + 4 < NT), (t + 2 < NT), (t + 2 < NT));     ENDW(t + 1); RESC(); ROT();
    }
    STEP(pB0, pB1, pA0, pA1, NT - 1, false, false, false); RESC();
    { float sacc = pB0[0] + pB0[1];
#pragma unroll
      for (int r = 2; r < 16; ++r) sacc += pB0[r];
#pragma unroll
      for (int r = 0; r < 16; ++r) sacc += pB1[r];
      l_reg += sacc;
      pw0 = (u32x4){PKW(pB0, 0), PKW(pB0, 2), PKW(pB0, 4), PKW(pB0, 6)}; pw1 = (u32x4){PKW(pB0, 8), PKW(pB0, 10), PKW(pB0, 12), PKW(pB0, 14)}; pw2 = (u32x4){PKW(pB1, 0), PKW(pB1, 2), PKW(pB1, 4), PKW(pB1, 6)}; pw3 = (u32x4){PKW(pB1, 8), PKW(pB1, 10), PKW(pB1, 12), PKW(pB1, 14)};
      ASBAR(); pv(o, (int)(unsigned)(__SIZE_TYPE__)(vp0 + sl_cur), PAF(0), PAF(1), PAF(2), PAF(3)); }
    if (nK) {
        asm volatile("s_waitcnt lgkmcnt(0)\n\ts_barrier" ::: "memory");
        glds16s(nK, koff, (unsigned)__builtin_amdgcn_readfirstlane(kdst)); glds16s(nV, voff, (unsigned)__builtin_amdgcn_readfirstlane(vdst)); glds16s(nK + (size_t)KVBLK * PITCH, koff, (unsigned)__builtin_amdgcn_readfirstlane(kdst + SLOTB));
        const f16* nQw = nQ + (size_t)(wid * QBLK) * PITCH;
#pragma unroll
        for (int d0 = 0; d0 < 4; ++d0) qr[d0] = *reinterpret_cast<const f16x8*>(&nQw[(size_t)r32 * PITCH + d0 * 16 + hi * 8]);
    }
#undef PKW
#undef PAF
#undef VFR
#undef PIN
#undef MX3
#undef GAPA
#undef GAPB
#undef EX
#undef VRD
#undef KRD
#undef STEP
#undef ENDW
    { auto rr = __builtin_amdgcn_permlane32_swap(__float_as_uint(l_reg), __float_as_uint(l_reg), false, false); l_reg = __uint_as_float(rr[0]) + __uint_as_float(rr[1]); }
    if (hi == 0) wsf[32 + r32] = l_reg; asm volatile("s_waitcnt lgkmcnt(0)" ::: "memory");
    float rli[16];
#pragma unroll
    for (int r = 0; r < 16; ++r) rli[r] = __builtin_amdgcn_rcpf(wsf[32 + crow(r, hi)]);
    f16* Ow = U.Op + (size_t)(wid * QBLK) * MIXW;
    { f16* stg = (f16*)(shm + LDS_OST) + wid * 2048;
#pragma unroll
      for (int r = 0; r < 16; ++r) { const int orow = crow(r, hi);
#pragma unroll
        for (int d0 = 0; d0 < 2; ++d0) stg[orow * 64 + d0 * 32 + r32] = (f16)(o[d0][r] * rli[r]); }
      asm volatile("s_waitcnt lgkmcnt(0)" ::: "memory");
#pragma unroll
      for (int i = 0; i < 4; ++i) { const int row = i * 8 + (lane >> 3), ch = lane & 7; const u32x4 v = *(const u32x4*)(stg + row * 64 + ch * 8); *(u32x4*)(Ow + (size_t)row * MIXW + ch * 8) = v;
        float f[8]; h8_to_f(v, f); float s = 0.f;
#pragma unroll
        for (int j = 0; j < 8; ++j) s += f[j] * f[j];
        s += __shfl_xor(s, 1); s += __shfl_xor(s, 2); s += __shfl_xor(s, 4);
        if (ch == 0) U.ssq[wid * QBLK + row] = s; } }
    if (!nK) asm volatile("s_waitcnt lgkmcnt(0)\n\ts_barrier" ::: "memory");
#undef DMA_K
#undef DMA_V
#undef NEGM
#undef HOOK
#undef START
#undef RESC
#undef ROT
}
#undef ASBAR
#undef WAIT_BAR
#undef MFMA32
}

constexpr int NWAVES = 8, NPHASE = 9;
constexpr int RING_BYTES = 131072, LDS_TOTAL = 163840;
constexpr int LDS_IDX16 = RING_BYTES + 64, LDS_RSS = LDS_IDX16 + 16 * CAP * 2;
enum { PH_PRO = 0, PH_QKV = 1, PH_ATT = 2, PH_OUT = 3, PH_ROUTER = 4, PH_TOPK = 5, PH_E1 = 6, PH_E2 = 7, PH_COMB = 8 };
struct MArgs { const float* in[16]; float* out; unsigned char* ws; int ph_lo, ph_hi; };

template <bool FP8, class RowMap, class KScale>
DEVI void p0_transpose_item(const float* __restrict__ W, int K, int N, void* __restrict__ WTv, LAS float* scr, int item, int lane, const RowMap& rm, const KScale& ks) {
    const int nblk = N / 32, kb = item / nblk, nb = item - kb * nblk, k0 = 64 * kb, n0 = 32 * nb;
#pragma unroll 8
    for (int i = 0; i < 32; ++i) { const int kk = 2 * i + (lane >> 5); scr[kk * 33 + (lane & 31)] = __builtin_nontemporal_load(W + (size_t)(k0 + kk) * N + n0 + (lane & 31)); }
    WAIT_L(0); asm volatile("" ::: "memory");
    const int c = lane & 7;
    float kv[8];
#pragma unroll
    for (int q = 0; q < 8; ++q) kv[q] = ks(k0 + 8 * c + q);
#pragma unroll
    for (int j = 0; j < 4; ++j) { const int n = (lane >> 3) + 8 * j; const LAS float* s = scr + (8 * c) * 33 + n;
        if constexpr (FP8) { u32x2 o; o.x = pk_f8x4(s[0 * 33] * kv[0], s[1 * 33] * kv[1], s[2 * 33] * kv[2], s[3 * 33] * kv[3]); o.y = pk_f8x4(s[4 * 33] * kv[4], s[5 * 33] * kv[5], s[6 * 33] * kv[6], s[7 * 33] * kv[7]);
            const int r_ = rm(n0 + n), kk_ = k0 + 8 * c;
            *(u32x2*)((unsigned char*)WTv + ((size_t)(r_ >> 8) * (K >> 7) + (kk_ >> 7)) * 32768 + (size_t)(r_ & 255) * 128 + (kk_ & 127)) = o; }
        else { u32x4 o; o.x = pk_h2(s[0 * 33] * kv[0], s[1 * 33] * kv[1]); o.y = pk_h2(s[2 * 33] * kv[2], s[3 * 33] * kv[3]); o.z = pk_h2(s[4 * 33] * kv[4], s[5 * 33] * kv[5]); o.w = pk_h2(s[6 * 33] * kv[6], s[7 * 33] * kv[7]);
            *(u32x4*)((f16*)WTv + (size_t)rm(n0 + n) * K + k0 + 8 * c) = o; } }
    WAIT_L(0); asm volatile("" ::: "memory");
}
struct RmSigma { DEVI int operator()(int n) const { return (n & ~255) + pg8::sigma_inv(n & 255); } };
struct RmGU { int up; DEVI int operator()(int f) const { const int pn = f >> 7, fl = f & 127; return 256 * pn + 128 * up + 32 * (fl >> 5) + 16 * ((fl >> 2) & 1) + 4 * ((fl >> 3) & 3) + (fl & 3); } };
struct KsOne { DEVI float operator()(int) const { return 1.f; } };
struct KsVec { const float* g; float sc; DEVI float operator()(int k) const { return g[k] * sc; } };
struct KsConst { float sc; DEVI float operator()(int) const { return sc; } };
struct KsOutG { const float *ga, *gb; DEVI float operator()(int k) const { return k < 512 ? ga[k] : gb[k - 512]; } };

DEVI void rmsnorm1_row(const float* __restrict__ xrow, float* __restrict__ rms_out, f16* __restrict__ orow, int lane) {
    const f32x4* xr = (const f32x4*)xrow + lane;
    f32x4 v[4]; float s = 0.f;
#pragma unroll
    for (int j = 0; j < 4; ++j) { v[j] = __builtin_nontemporal_load(xr + 64 * j); s += (v[j].x * v[j].x + v[j].y * v[j].y) + (v[j].z * v[j].z + v[j].w * v[j].w); }
    const float rstd = rsqrtf(wave_sum(s) * (1.f / DM) + EPS);
    if (lane == 0) *rms_out = 1.f / rstd;
    u32x2* o = (u32x2*)orow + lane;
#pragma unroll
    for (int j = 0; j < 4; ++j) { u32x2 w; w.x = pk_h2(v[j].x * rstd, v[j].y * rstd); w.y = pk_h2(v[j].z * rstd, v[j].w * rstd); o[64 * j] = w; }
}

DEVI void router_phase(LAS unsigned char* lds, const float* __restrict__ h, const float* __restrict__ g2, const float* __restrict__ wr, float* __restrict__ aff, float* __restrict__ rstd2, int bid, int G, const int wave) {
    LAS f32x4* wr4 = (LAS f32x4*)lds;
    const int lane = lane_id_v(), tid = wave * 64 + lane;
    for (int i = tid; i < DM * 4; i += 512) { const int k = i >> 2, c4 = i & 3; const f32x4 w = ((const f32x4*)wr)[i] * g2[k]; wr4[k * 4 + (c4 ^ ((k >> 2) & 3))] = w; }
    __syncthreads();
    const int sw = (lane >> 2) & 3;
#define RT_LOAD(dst, t_) do { const float* hp_ = h + (size_t)(t_) * DM + lane; _Pragma("unroll") for (int i = 0; i < 16; ++i) dst[i] = hp_[64 * i]; } while (0)
#define RT_ROW(src, t_) do { float ssq = 0.f; float lg[16]; \
        _Pragma("unroll") for (int e = 0; e < 16; ++e) lg[e] = 0.f; \
        _Pragma("unroll") for (int i = 0; i < 16; ++i) { const int k = lane + 64 * i; const float hv = src[i]; ssq += hv * hv; \
            _Pragma("unroll") for (int c4 = 0; c4 < 4; ++c4) { const f32x4 w = wr4[k * 4 + (c4 ^ sw)]; lg[4 * c4 + 0] += hv * w.x; lg[4 * c4 + 1] += hv * w.y; lg[4 * c4 + 2] += hv * w.z; lg[4 * c4 + 3] += hv * w.w; } if ((i & 1) == 1) SCHED0; } \
        const float rs = rsqrtf(wave_sum(ssq) * (1.f / DM) + EPS); float mx = -1e30f; \
        _Pragma("unroll") for (int e = 0; e < 16; ++e) { lg[e] = wave_sum(lg[e]) * rs; mx = fmaxf(mx, lg[e]); } \
        float sum = 0.f; \
        _Pragma("unroll") for (int e = 0; e < 16; ++e) { lg[e] = __expf(lg[e] - mx); sum += lg[e]; } \
        float mine = 0.f; \
        _Pragma("unroll") for (int e = 0; e < 16; ++e) mine = (lane == e) ? lg[e] : mine; \
        const int b_ = (t_) >> 11, tt_ = (t_) & (SEQ - 1); \
        if (lane < 16) aff[((size_t)b_ * NEXP + lane) * SEQ + tt_] = mine / sum; \
        if (lane == 0) rstd2[t_] = rs; } while (0)
    for (int item = bid; item < MTOK / 128; item += G) {
        const int t0 = item * 128 + wave * 16;
        float ha[16], hb[16];
        RT_LOAD(ha, t0);
        for (int r = 0; r < 16; r += 2) {
            RT_LOAD(hb, t0 + r + 1);
            RT_ROW(ha, t0 + r);
            if (r + 2 < 16) RT_LOAD(ha, t0 + r + 2);
            RT_ROW(hb, t0 + r + 1);
        }
    }
#undef RT_LOAD
#undef RT_ROW
    __syncthreads();
}
DEVI int lds_block_sum512(int v, LAS int* red, int tid) {
    const int lane = tid & 63, wave = tid >> 6;
#pragma unroll
    for (int o = 1; o < 64; o <<= 1) v += __shfl_xor(v, o);
    if (lane == 0) red[wave] = v;
    __syncthreads();
    int s = 0;
#pragma unroll
    for (int w = 0; w < 8; ++w) s += red[w];
    return s;
}
DEVI int lds_block_excl_scan512(int v, LAS int* red, int tid) {
    const int lane = tid & 63, wave = tid >> 6;
    int inc = v;
#pragma unroll
    for (int o = 1; o < 64; o <<= 1) { const int n = __shfl_up(inc, o); if (lane >= o) inc += n; }
    if (lane == 63) red[wave] = inc;
    __syncthreads();
    int base = 0;
#pragma unroll
    for (int w = 0; w < 8; ++w) base += (w < wave) ? red[w] : 0;
    return base + inc - v;
}
DEVI void topk_phase(LAS unsigned char* lds, const float* __restrict__ aff, const float* __restrict__ rstd2, int* __restrict__ idx, float* __restrict__ rss, float* __restrict__ gate, short* __restrict__ inv, int bid, int G, const int wave) {
    LAS int* red = (LAS int*)lds;
    const int tid = wave * 64 + lane_id_v();
    for (int be = bid; be < NB * NEXP; be += G) {
        const int b = be >> 4, e = be & 15;
        const f32x4 a4 = ((const f32x4*)(aff + (size_t)be * SEQ))[tid];
        const float av[4] = {a4.x, a4.y, a4.z, a4.w};
        unsigned bits[4];
#pragma unroll
        for (int j = 0; j < 4; ++j) bits[j] = __float_as_uint(av[j]);
        unsigned lo = 0u, hi = 0x7f800000u; int it = 0;
        while (lo < hi) {
            const unsigned mid = lo + ((hi - lo + 1u) >> 1);
            int c = 0;
#pragma unroll
            for (int j = 0; j < 4; ++j) c += (bits[j] >= mid) ? 1 : 0;
            const int tot = lds_block_sum512(c, red + 8 * (it & 1), tid);
            if (tot >= CAP) lo = mid; else hi = mid - 1u;
            ++it;
        }
        const unsigned theta = lo;
        int cgt = 0, ceq = 0;
#pragma unroll
        for (int j = 0; j < 4; ++j) { cgt += (bits[j] > theta) ? 1 : 0; ceq += (bits[j] == theta) ? 1 : 0; }
        const int ngt = lds_block_sum512(cgt, red + 16, tid);
        const int need = CAP - ngt;
        int eqr = lds_block_excl_scan512(ceq, red + 24, tid);
        int sel[4]; int csel = 0;
#pragma unroll
        for (int j = 0; j < 4; ++j) { const bool eq = bits[j] == theta; sel[j] = (bits[j] > theta || (eq && eqr < need)) ? 1 : 0; eqr += eq ? 1 : 0; csel += sel[j]; }
        __syncthreads();
        int slot = lds_block_excl_scan512(csel, red, tid);
#pragma unroll
        for (int j = 0; j < 4; ++j) {
            const int t = 4 * tid + j; short s = -1;
            if (sel[j]) { s = (short)slot; idx[be * CAP + slot] = t; gate[be * CAP + slot] = av[j]; rss[be * CAP + slot] = rstd2[b * SEQ + t]; ++slot; }
            inv[(size_t)be * SEQ + t] = s;
        }
        __syncthreads();
    }
}
DEVI int wave_isum(int v) {
#pragma unroll
    for (int o = 1; o < 64; o <<= 1) v += __shfl_xor(v, o);
    return v;
}
DEVI int wave_excl_scan(int v, int lane) {
    int inc = v;
#pragma unroll
    for (int o = 1; o < 64; o <<= 1) { const int n = __shfl_up(inc, o); if (lane >= o) inc += n; }
    return inc - v;
}
DEVI void topk_wave(const float* __restrict__ aff, const float* __restrict__ rstd2, int* __restrict__ idx, float* __restrict__ rss, float* __restrict__ gate, short* __restrict__ inv, int be, int lane) {
    const int b = be >> 4;
    const f32x4* ap = (const f32x4*)(aff + (size_t)be * SEQ + 32 * lane);
    unsigned bits[32];
#pragma unroll
    for (int q = 0; q < 8; ++q) { const f32x4 a = ap[q]; bits[4 * q] = __float_as_uint(a.x); bits[4 * q + 1] = __float_as_uint(a.y); bits[4 * q + 2] = __float_as_uint(a.z); bits[4 * q + 3] = __float_as_uint(a.w); }
    unsigned lo = 0u, hi = 0x7f800000u;
    while (lo < hi) {
        const unsigned mid = lo + ((hi - lo + 1u) >> 1);
        int c = 0;
#pragma unroll
        for (int j = 0; j < 32; ++j) c += (bits[j] >= mid) ? 1 : 0;
        const int tot = __builtin_amdgcn_readfirstlane(wave_isum(c));
        if (tot >= CAP) lo = mid; else hi = mid - 1u;
    }
    const unsigned theta = lo;
    int cgt = 0, ceq = 0;
#pragma unroll
    for (int j = 0; j < 32; ++j) { cgt += (bits[j] > theta) ? 1 : 0; ceq += (bits[j] == theta) ? 1 : 0; }
    const int need = CAP - wave_isum(cgt);
    int eqr = wave_excl_scan(ceq, lane);
    unsigned selm = 0u; int csel = 0;
#pragma unroll
    for (int j = 0; j < 32; ++j) { const bool eq = bits[j] == theta; const bool sl = (bits[j] > theta) || (eq && eqr < need); eqr += eq ? 1 : 0; selm |= sl ? (1u << j) : 0u; csel += sl ? 1 : 0; }
    int slot = wave_excl_scan(csel, lane);
    const f32x4* rp = (const f32x4*)(rstd2 + (size_t)b * SEQ + 32 * lane);
    u32x4* ip = (u32x4*)(inv + (size_t)be * SEQ + 32 * lane);
#pragma unroll
    for (int q = 0; q < 4; ++q) {
        unsigned w[4];
#pragma unroll
        for (int h = 0; h < 2; ++h) { const f32x4 rs = rp[2 * q + h];
#pragma unroll
            for (int i = 0; i < 4; ++i) { const int j = 8 * q + 4 * h + i; unsigned s16 = 0xFFFFu;
                if ((selm >> j) & 1u) { s16 = (unsigned)slot; idx[be * CAP + slot] = 32 * lane + j; gate[be * CAP + slot] = __uint_as_float(bits[j]); rss[be * CAP + slot] = rs[i]; ++slot; }
                if (i & 1) w[2 * h + (i >> 1)] |= s16 << 16; else w[2 * h + (i >> 1)] = s16; } }
        u32x4 o; o.x = w[0]; o.y = w[1]; o.z = w[2]; o.w = w[3]; ip[q] = o;
    }
}
DEVI void combine_acc(f32x4 (&v)[4], const f16* __restrict__ y, const short* __restrict__ invt, int row, int lane) {
    const int b = row >> 11, tt = row & (SEQ - 1);
    int sl[NEXP];
#pragma unroll
    for (int e = 0; e < NEXP; ++e) { const unsigned idx = (unsigned)((b * NEXP + e) * SEQ + tt); const unsigned w = ((const unsigned*)invt)[idx >> 1]; sl[e] = (int)(short)(w >> (16 * (idx & 1))); }
#pragma unroll
    for (int e = 0; e < NEXP; ++e) {
        const int s = sl[e];
        if (s >= 0) {
            const unsigned* yr = (const unsigned*)((const unsigned char*)y + ((size_t)(b * NEXP + e) * CAP + s) * DM) + lane;
#pragma unroll
            for (int j = 0; j < 4; ++j) { const unsigned w = yr[64 * j]; const auto lo = __builtin_amdgcn_cvt_pk_f32_fp8((int)w, false), hi = __builtin_amdgcn_cvt_pk_f32_fp8((int)w, true);
                v[j].x += lo[0]; v[j].y += lo[1]; v[j].z += hi[0]; v[j].w += hi[1]; }
        }
    }
}
DEVI void combine_rows2(float* __restrict__ out, const f16* __restrict__ h16, const f16* __restrict__ y, const short* __restrict__ inv, int row0, int row1, int lane) {
    const u32x2* h0 = (const u32x2*)(h16 + (size_t)row0 * DM) + lane; const u32x2* h1 = (const u32x2*)(h16 + (size_t)row1 * DM) + lane;
    f32x4 v0[4], v1[4];
#pragma unroll
    for (int j = 0; j < 4; ++j) { const f16x4 p = __builtin_bit_cast(f16x4, h0[64 * j]), q = __builtin_bit_cast(f16x4, h1[64 * j]);
        v0[j] = (f32x4){(float)p[0], (float)p[1], (float)p[2], (float)p[3]} * Y_SCALE; v1[j] = (f32x4){(float)q[0], (float)q[1], (float)q[2], (float)q[3]} * Y_SCALE; }
    combine_acc(v0, y, inv, row0, lane);
    combine_acc(v1, y, inv, row1, lane);
#pragma unroll
    for (int j = 0; j < 4; ++j) { v0[j] = v0[j] * (1.f / Y_SCALE); v1[j] = v1[j] * (1.f / Y_SCALE); }
    f32x4* o0 = (f32x4*)(out + (size_t)row0 * DM) + lane; f32x4* o1 = (f32x4*)(out + (size_t)row1 * DM) + lane;
#pragma unroll
    for (int j = 0; j < 4; ++j) { o0[64 * j] = v0[j]; o1[64 * j] = v1[j]; }
}

#define XB_TMO      128
#define XB_XCNT(j)  (256  + 64 * (j))
#define XB_XSUB(j)  (1280 + 64 * (j))
#define XB_XGEN(j)  (2304 + 64 * (j))
#define XB_TOP      3328
#define XB_TOPGEN   3392
#define XCD_BAR_WORDS 3456
#define XB_SPIN_CAP (1u << 22)
DEVI unsigned xb_ld(unsigned* p)              { return __hip_atomic_load(p, __ATOMIC_RELAXED, __HIP_MEMORY_SCOPE_AGENT); }
DEVI unsigned xb_add(unsigned* p, unsigned v) { return __hip_atomic_fetch_add(p, v, __ATOMIC_RELAXED, __HIP_MEMORY_SCOPE_AGENT); }
DEVI unsigned xb_xcc_id() { return (unsigned)__builtin_amdgcn_s_getreg((3 << 11) | 20) & 0xFu; }
#define XB_SPIN(cond, bar) do { unsigned _sp = 0; while (cond) { __builtin_amdgcn_s_sleep(1); \
    if ((++_sp & 255u) == 0u) { if (xb_ld(&(bar)[XB_TMO])) break; if (_sp > XB_SPIN_CAP) { atomicAdd(&(bar)[XB_TMO], 1u); break; } } } } while (0)
struct XcdBarrier { unsigned* bar; unsigned x; volatile LAS unsigned* st; };
DEVI XcdBarrier xcd_barrier_post(unsigned* bar, volatile LAS unsigned* st, bool leader) {
    XcdBarrier b; b.bar = bar; b.x = xb_xcc_id(); b.st = st;
    if (leader) (void)xb_add(&bar[XB_XCNT(b.x)], 1u);
    return b;
}
DEVI void xcd_barrier_complete(unsigned* bar, unsigned x, unsigned& nloc, unsigned& nx) {
    const unsigned G = gridDim.x;
    unsigned sum, cnt, mine, sp = 0u;
    for (;;) {
        sum = 0u; cnt = 0u; mine = 0u;
#pragma unroll
        for (unsigned j = 0; j < 16; ++j) { const unsigned c = xb_ld(&bar[XB_XCNT(j)]); sum += c; cnt += (c > 0u) ? 1u : 0u; mine = (j == x) ? c : mine; }
        if (sum == G) break;
        __builtin_amdgcn_s_sleep(1);
        if ((++sp & 255u) == 0u) { if (xb_ld(&bar[XB_TMO])) break; if (sp > XB_SPIN_CAP) { atomicAdd(&bar[XB_TMO], 1u); break; } }
    }
    nloc = mine > 0u ? mine : 1u; nx = cnt > 0u ? cnt : 1u;
}
DEVI void xcd_barrier_leader(const XcdBarrier& b) {
    {
        unsigned* bar = b.bar;
        __builtin_amdgcn_s_waitcnt(0);
        unsigned nloc = b.st[0], nx = b.st[1];
        if (nloc == 0u) { xcd_barrier_complete(bar, b.x, nloc, nx); b.st[0] = nloc; b.st[1] = nx; }
        const unsigned old = xb_add(&bar[XB_XSUB(b.x)], 1u);
        const unsigned gen = old / nloc;
        if (old + 1u == (gen + 1u) * nloc) {
            __builtin_amdgcn_fence(__ATOMIC_RELEASE, "agent");
            asm volatile("s_waitcnt vmcnt(0)" ::: "memory");
            const unsigned og = xb_add(&bar[XB_TOP], 1u);
            const unsigned tg = og / nx;
            if (og + 1u == (tg + 1u) * nx) xb_add(&bar[XB_TOPGEN], 1u);
            else XB_SPIN(xb_ld(&bar[XB_TOPGEN]) == tg, bar);
            __builtin_amdgcn_fence(__ATOMIC_ACQUIRE, "agent");
            xb_add(&bar[XB_XGEN(b.x)], 1u);
            asm volatile("s_waitcnt vmcnt(0)" ::: "memory");
        } else {
            XB_SPIN(xb_ld(&bar[XB_XGEN(b.x)]) == gen, bar);
            __builtin_amdgcn_fence(__ATOMIC_ACQUIRE, "agent");
            asm volatile("s_waitcnt vmcnt(0)" ::: "memory");
        }
    }
}
DEVI void xcd_barrier(const XcdBarrier& b, bool leader) {
    asm volatile("s_waitcnt vmcnt(0)" ::: "memory");
    __syncthreads();
    if (leader) xcd_barrier_leader(b);
    __syncthreads();
}

__global__ void __launch_bounds__(NWAVES * 64, 2) mega_fwd(MArgs args) {
    __builtin_assume(__builtin_amdgcn_workitem_id_y() == 0); __builtin_assume(__builtin_amdgcn_workitem_id_z() == 0);
    extern __shared__ __attribute__((aligned(16))) unsigned char lds_raw[];
    LAS unsigned char* lds = (LAS unsigned char*)lds_raw;
    const int wave = __builtin_amdgcn_readfirstlane((int)threadIdx.x >> 6);
    const int G = gridDim.x, bx = blockIdx.x, vcu = (G % 8 == 0) ? (bx % 8) * (G / 8) + bx / 8 : bx;
    const float* x = args.in[0]; const float* norm1_g = args.in[1]; const float* w_in = args.in[2];
    const float* g_naq = args.in[3]; const float* g_nak = args.in[4]; const float* rpb = args.in[5];
    const float* g_gq = args.in[6]; const float* g_gk = args.in[7]; const float* g_oa = args.in[8]; const float* g_ob = args.in[9];
    const float* w_out = args.in[10]; const float* norm2_g = args.in[11]; const float* w_router = args.in[12];
    const float* w_gate = args.in[13]; const float* w_up = args.in[14]; const float* w_down = args.in[15];
    float* out = args.out; unsigned char* ws = args.ws;
    f16* XN = (f16*)(ws + WS_XN); f16* H16 = (f16*)(ws + WS_H16); f16* PROJ = (f16*)(ws + WS_PROJ); f16* ATT = (f16*)(ws + WS_ATT); unsigned char* ACT = ws + WS_ACT; f16* Y = (f16*)(ws + WS_Y); unsigned char* H8 = ws + WS_H8;
    f16* WinT = (f16*)(ws + WS_WINT); f16* WoT = (f16*)(ws + WS_WOT); unsigned char* W1T = ws + WS_W1T; unsigned char* W2T = ws + WS_W2T;
    float* SSQP = (float*)(ws + WS_SSQP); float* AFF = (float*)(ws + WS_AFF); float* RSTD2 = (float*)(ws + WS_RSTD2);
    int* IDX = (int*)(ws + WS_IDX); float* RSS = (float*)(ws + WS_RSS); float* GATE = (float*)(ws + WS_GATE); short* INV = (short*)(ws + WS_INV);
    const int lo = args.ph_lo, hi = args.ph_hi;
#ifndef PH_BUILD
#define PH_BUILD 0x1FF
#endif
#define IN(k) (((PH_BUILD >> (k)) & 1) && lo <= (k) && (k) < hi)
#ifndef REPEAT_PH
#define REPEAT_PH -1
#endif
#ifndef REPEAT_N
#define REPEAT_N 2
#endif
#define REPS(k) for (int rep_ = 0; rep_ < ((REPEAT_PH == (k)) ? REPEAT_N : 1); ++rep_)
#define REPBAR() do { if (rep_ > 0) xcd_barrier(gbar, (wave == 0) && (lane_id_v() == 0)); } while (0)
    volatile LAS unsigned* MISC = (volatile LAS unsigned*)(lds + RING_BYTES);
    const bool leader = (wave == 0) && (lane_id_v() == 0);
    if (leader) { MISC[0] = 0u; MISC[1] = 0u; }
    if (lane_id_v() == 0) MISC[8 + wave] = 0u;
    __syncthreads();
    XcdBarrier gbar; gbar.bar = (unsigned*)(ws + WS_CTL); gbar.x = 0; gbar.st = MISC;
    if (hi - lo > 1 || REPEAT_PH >= 0) gbar = xcd_barrier_post((unsigned*)(ws + WS_CTL), MISC, leader);
#define SEAM(k) do { if (IN(k) && IN((k) + 1)) { xcd_barrier(gbar, (wave == 0) && (lane_id_v() == 0)); } } while (0)
    constexpr int CV_I_GU = (DM / 64) * (DEXP / 32), CV_I_DN = (DEXP / 64) * (DM / 32), CV_N_IT = NEXP * (2 * CV_I_GU + CV_I_DN);
#define CONV_ITEM(it_, scr_, lane_) do { const int e_ = (it_) / (2 * CV_I_GU + CV_I_DN); int r_ = (it_) - e_ * (2 * CV_I_GU + CV_I_DN); \
        if (r_ < CV_I_GU) p0_transpose_item<true>(w_gate + (size_t)e_ * DM * DEXP, DM, DEXP, W1T + (size_t)e_ * 5632 * DM, scr_, r_, lane_, RmGU{0}, KsVec{norm2_g, W_SCALE}); \
        else if (r_ < 2 * CV_I_GU) p0_transpose_item<true>(w_up + (size_t)e_ * DM * DEXP, DM, DEXP, W1T + (size_t)e_ * 5632 * DM, scr_, r_ - CV_I_GU, lane_, RmGU{1}, KsVec{norm2_g, W_SCALE}); \
        else p0_transpose_item<true>(w_down + (size_t)e_ * DEXP * DM, DEXP, DM, W2T + (size_t)e_ * DM * DEXP, scr_, r_ - 2 * CV_I_GU, lane_, RmSigma{}, KsConst{W_SCALE}); } while (0)
    constexpr int CV_POOL = CV_N_IT / 8;
    static_assert(CV_N_IT % 8 == 0, "pools");
    const int cvpool = bx & 7;
    unsigned* cvhead = (unsigned*)(ws + WS_CTL + 57344) + 64 * cvpool;
#define CV_DEQ() ((lane_id_v() == 0) ? __hip_atomic_fetch_add(cvhead, 1u, __ATOMIC_RELAXED, __HIP_MEMORY_SCOPE_AGENT) : 0u)
#define CV_SESSION(STOPPABLE) do { const int lane_ = lane_id_v(); LAS float* scr_ = (LAS float*)(lds + 4096 + wave * 16384); \
        unsigned cur_ = MISC[8 + wave]; \
        if (cur_ == 0u) cur_ = (unsigned)__builtin_amdgcn_readfirstlane(CV_DEQ()) + 1u; \
        for (;;) { \
            if (cur_ - 1u >= (unsigned)CV_POOL) { cur_ = (unsigned)CV_POOL + 1u; break; }        \
            const unsigned pend_ = CV_DEQ(); \
            CONV_ITEM((int)(cur_ - 1u) * 8 + cvpool, scr_, lane_); \
            cur_ = (unsigned)__builtin_amdgcn_readfirstlane(pend_) + 1u; \
            if ((STOPPABLE) && MISC[5] != 0u) break; } \
        MISC[8 + wave] = cur_; } while (0)
#define SEAM_CV(k) do { if (IN(k) && IN((k) + 1)) { \
        asm volatile("s_waitcnt vmcnt(0)" ::: "memory"); \
        if (leader) MISC[5] = 0u; \
        __syncthreads(); \
        if (wave == 0) { if (leader) { xcd_barrier_leader(gbar); MISC[5] = 1u; } } \
        else { if (MISC[8 + wave] != (unsigned)CV_POOL + 1u) CV_SESSION(true); } \
        __syncthreads(); } } while (0)

    if (IN(PH_PRO)) REPS(PH_PRO) {
        REPBAR();
        const int lane = lane_id_v();
        LAS float* scr = (LAS float*)(lds + wave * 16384);
        const int gw = vcu * NWAVES + wave, NGW = G * NWAVES;
        constexpr int I_IN = (DM / 64) * (INW / 32), I_OUT = (DM / 64) * (DM / 32), I_GU = (DM / 64) * (DEXP / 32), I_DN = (DEXP / 64) * (DM / 32);
        for (int it = gw; it < I_IN + I_OUT; it += NGW) {
            int r = it;
            if (r < I_IN) { p0_transpose_item<false>(w_in, DM, INW, WinT, scr, r, lane, RmSigma{}, KsVec{norm1_g, 1.f}); continue; } r -= I_IN;
            p0_transpose_item<false>(w_out, MIXW, DM, WoT, scr, r, lane, RmSigma{}, KsOutG{g_oa, g_ob});
        }
        for (int m = gw; m < MTOK; m += NGW) rmsnorm1_row(x + (size_t)m * DM, (float*)(ws + WS_RMS1) + m, XN + (size_t)m * DM, lane);
        { f16* WRT = (f16*)(ws + WS_WRT);
          for (int i = gw * 64 + lane; i < NEXP * DM; i += NGW * 64) { const int e = i >> 10, k = i & (DM - 1); const float w = w_router[k * NEXP + e] * norm2_g[k]; const f16 hi = (f16)w; WRT[i] = hi; WRT[NEXP * DM + i] = (f16)(w - (float)hi); } }
        __syncthreads();
    }
    SEAM_CV(PH_PRO);
    if (IN(PH_QKV)) REPS(PH_QKV) {
        REPBAR();
        pg8::SchedDense S; S.init(XN, WinT, MTOK, INW, DM, G, bx);
        pg8::EpiQKV E{PROJ, g_naq, g_nak, g_gq, g_gk};
        pg8::gemm_phase<pg8::EpiQKV, pg8::SchedDense, true, false>(lds, DM, S, E, wave);
    }
    SEAM_CV(PH_QKV);
    if (IN(PH_ATT)) REPS(PH_ATT) {
        REPBAR();
        for (int u = vcu; u < 256; u += G) {
            const int bkv = u >> 3, b = bkv >> 1, kvh = bkv & 1, qb = u & 7;
            f16x8 qfr[4];
#pragma unroll 1
            for (int i = 0; i < 4; ++i) { const int hq = kvh * 4 + i; const size_t row0 = (size_t)b * SEQ + qb * 256;
                attn_body::AttnU U{PROJ + row0 * INW + C_GQ + hq * 64, PROJ + (size_t)b * SEQ * INW + C_GK + kvh * 64, PROJ + (size_t)b * SEQ * INW + C_GV + kvh * 64,
                                   ATT + row0 * MIXW + 512 + hq * 64, SSQP + (size_t)(8 + hq) * MTOK + row0, 32, 0, 0, nullptr};
                const bool more = i < 3;
                attn_body::attn_unit<8, 0>(U, U.Qp + 64, more ? U.Kp : nullptr, U.Vp, i > 0, qfr, (char*)lds_raw, wave);
            }
        }
        asm volatile("" ::: "memory");
        for (int u = vcu; u < 256; u += G) {
            const int pr = u >> 1, b = pr >> 3, h = pr & 7;
            f16x8 qfrn[4];
#pragma unroll 1
            for (int i = 0; i < 4; ++i) { const int rb = (u & 1) * 4 + i, r0 = rb * 4; int kr0 = r0 - 4; kr0 = kr0 < 0 ? 0 : (kr0 > GROWS - 8 ? GROWS - 8 : kr0);
                const int NT = (rb == 0 || rb == 7) ? 8 : 12; const size_t row0 = (size_t)b * SEQ + r0 * GRIDW, krow0 = (size_t)b * SEQ + kr0 * GRIDW;
                attn_body::AttnU U{PROJ + row0 * INW + C_NAQ + h * 64, PROJ + krow0 * INW + C_NAK + h * 64, PROJ + krow0 * INW + C_NAV + h * 64,
                                   ATT + row0 * MIXW + h * 64, SSQP + (size_t)h * MTOK + row0, NT, r0, kr0, rpb + h * 465};
                const bool more = i < 3;
                int nkr0 = r0 + 4 - 4; nkr0 = nkr0 < 0 ? 0 : (nkr0 > GROWS - 8 ? GROWS - 8 : nkr0); const size_t nrow0 = (size_t)b * SEQ + (r0 + 4) * GRIDW, nkrow0 = (size_t)b * SEQ + nkr0 * GRIDW;
                attn_body::attn_unit<8, 1>(U, PROJ + nrow0 * INW + C_NAQ + h * 64, more ? PROJ + nkrow0 * INW + C_NAK + h * 64 : nullptr, PROJ + nkrow0 * INW + C_NAV + h * 64, i > 0, qfrn, (char*)lds_raw, wave);
            }
        }
    }
    SEAM_CV(PH_ATT);
    if (IN(PH_OUT)) REPS(PH_OUT) {
        REPBAR();
        pg8::SchedDense S; S.init(ATT, WoT, MTOK, DM, MIXW, G, bx);
        LAS f32x2* rab = (LAS f32x2*)(lds + RING_BYTES + 64);
        pg8::EpiOut E{XN, (const float*)(ws + WS_RMS1), H16, rab, SSQP, H8, (const f16*)(ws + WS_WRT), (float*)(ws + WS_PART), (float*)(ws + WS_SSQ2P), (unsigned*)(ws + WS_PCNT), AFF, RSTD2, MISC};
        pg8::gemm_phase<pg8::EpiOut, pg8::SchedDense, true, false>(lds, MIXW, S, E, wave);
    }
    SEAM_CV(PH_OUT);
    if (IN(PH_TOPK)) REPS(PH_TOPK) { REPBAR();
        {
            const int lane = lane_id_v();
            if (wave == 0) for (int be = bx; be < NB * NEXP; be += G) topk_wave(AFF, RSTD2, IDX, RSS, GATE, INV, be, lane);
            LAS float* scr = (LAS float*)(lds + 4096 + wave * 16384);
            const int NGW = G * NWAVES;
            CV_SESSION(false);
            __syncthreads();
        } }
    SEAM(PH_TOPK);
    if (IN(PH_E1)) REPS(PH_E1) {
        REPBAR();
        pg8::SchedE1 S{(const char*)H8, (const char*)W1T, (const LAS unsigned short*)(lds + LDS_IDX16), G, vcu};
        {
            const int b_ = S.batch_of(), tid_ = wave * 64 + lane_id_v();
            LAS unsigned short* wi = (LAS unsigned short*)(lds + LDS_IDX16); LAS float* wr_ = (LAS float*)(lds + LDS_RSS);
            for (int i = tid_; i < NEXP * CAP; i += NWAVES * 64) { wi[i] = (unsigned short)IDX[b_ * NEXP * CAP + i]; wr_[i] = RSS[b_ * NEXP * CAP + i]; }
            __syncthreads();
        }
        pg8::EpiAct E{ACT, (const LAS float*)(lds + LDS_RSS)};
        pg8::gemm_phase<pg8::EpiAct, pg8::SchedE1, true, true>(lds, DM, S, E, wave);
    }
    SEAM(PH_E1);
    if (IN(PH_E2)) REPS(PH_E2) {
        REPBAR();
        pg8::SchedE2 S{(const char*)ACT, (const char*)W2T, G, vcu};
        pg8::EpiY E{Y, GATE};
        pg8::gemm_phase<pg8::EpiY, pg8::SchedE2, true, true>(lds, DEXP, S, E, wave);
    }
    SEAM(PH_E2);
    if (IN(PH_COMB)) REPS(PH_COMB) {
        REPBAR();
        const int lane = lane_id_v();
        const int gw = vcu * NWAVES + wave, NGW = G * NWAVES;
        for (int m = gw; m < MTOK; m += 2 * NGW) combine_rows2(out, H16, Y, INV, m, m + NGW, lane);
    }
#undef IN
#undef SEAM
}

#ifndef MEGA_MASK
#define MEGA_MASK 0x1FF
#endif
#ifndef ONE_LAUNCH
#define ONE_LAUNCH 1
#endif
static_assert(MEGA_MASK == 0x1FF && ONE_LAUNCH == 1, "the fp8 expert path needs the persistent-kernel forms of P0, P3, E1 and E2 (the simple kernels use the older f16 buffers)");
extern "C" void kernel_launch(void* const* d_in, const int* in_sizes, int n_in, void* d_out, int out_size, void* d_ws, size_t ws_size, hipStream_t stream) {
    static int grid = 0;
    if (grid == 0) {
        if (n_in != 16 || out_size != MTOK * DM || ws_size < WS_END) { fprintf(stderr, "kernel_launch: unexpected shapes (n_in %d out %d ws %zu, need %zu)\n", n_in, out_size, ws_size, (size_t)WS_END); grid = -1; return; }
        int dev = 0, cus = 0, per_cu = 0;
        if (hipGetDevice(&dev) != hipSuccess || hipDeviceGetAttribute(&cus, hipDeviceAttributeMultiprocessorCount, dev) != hipSuccess) { grid = -1; return; }
        if (hipFuncSetAttribute((const void*)mega_fwd, hipFuncAttributeMaxDynamicSharedMemorySize, LDS_TOTAL) != hipSuccess) { fprintf(stderr, "kernel_launch: hipFuncSetAttribute failed\n"); grid = -1; return; }
        if (hipOccupancyMaxActiveBlocksPerMultiprocessor(&per_cu, (const void*)mega_fwd, NWAVES * 64, LDS_TOTAL) != hipSuccess || per_cu < 1) { fprintf(stderr, "kernel_launch: occupancy query says %d\n", per_cu); per_cu = 1; }
        (void)hipGetLastError();
        grid = cus * 1;
        if (grid % 16 != 0 || grid < 64) { fprintf(stderr, "kernel_launch: %d CUs: the expert phase needs a grid that is a multiple of 16\n", cus); grid = -1; return; }
    }
    if (grid < 0) return;
    const float* x = (const float*)d_in[0]; const float* norm1_g = (const float*)d_in[1]; const float* w_in = (const float*)d_in[2];
    const float* g_naq = (const float*)d_in[3]; const float* g_nak = (const float*)d_in[4]; const float* rpb = (const float*)d_in[5];
    const float* g_gq = (const float*)d_in[6]; const float* g_gk = (const float*)d_in[7]; const float* g_oa = (const float*)d_in[8]; const float* g_ob = (const float*)d_in[9];
    const float* w_out = (const float*)d_in[10]; const float* norm2_g = (const float*)d_in[11]; const float* w_router = (const float*)d_in[12];
    const float* w_gate = (const float*)d_in[13]; const float* w_up = (const float*)d_in[14]; const float* w_down = (const float*)d_in[15];
    float* out = (float*)d_out; char* ws = (char*)d_ws;
    f16* XN = (f16*)(ws + WS_XN); f16* H16 = (f16*)(ws + WS_H16); f16* PROJ = (f16*)(ws + WS_PROJ); f16* ATT = (f16*)(ws + WS_ATT); f16* ACT = (f16*)(ws + WS_ACT); f16* Y = (f16*)(ws + WS_Y);
    float* SSQP = (float*)(ws + WS_SSQP); float* AFF = (float*)(ws + WS_AFF); float* RSTD2 = (float*)(ws + WS_RSTD2);
    int* IDX = (int*)(ws + WS_IDX); float* RSS = (float*)(ws + WS_RSS); float* GATE = (float*)(ws + WS_GATE); short* INV = (short*)(ws + WS_INV);
    f16* MIXED = (f16*)(ws + 560 * MiB);
    MArgs a{};
    for (int i = 0; i < 16; ++i) a.in[i] = (const float*)d_in[i];
    a.out = out; a.ws = (unsigned char*)d_ws;
    int p = 0;
    while (p < NPHASE) {
        if ((MEGA_MASK >> p) & 1) {
            int q = p + 1;
            if (ONE_LAUNCH) while (q < NPHASE && ((MEGA_MASK >> q) & 1)) ++q;
            a.ph_lo = p; a.ph_hi = q;
            if (q - p > 1 || REPEAT_PH >= 0) (void)hipMemsetAsync((char*)d_ws + WS_CTL, 0, CTL_ZERO_BYTES, stream);
            void* kargs[] = {&a};
            hipError_t e = hipLaunchCooperativeKernel((const void*)mega_fwd, dim3(grid), dim3(NWAVES * 64), kargs, LDS_TOTAL, stream);
            if (e != hipSuccess) fprintf(stderr, "kernel_launch: cooperative launch failed: %s (grid %d)\n", hipGetErrorString(e), grid);
            p = q; continue;
        }
        switch (p) {
        case PH_PRO: k_rmsnorm1<<<MTOK / 4, 256, 0, stream>>>(x, norm1_g, XN); break;
        case PH_QKV: k_ngemm<1><<<dim3(INW / 64, MTOK / 64), 256, 0, stream>>>((long)DM, (const float*)nullptr, RpPlain{XN, DM, 0}, WpPlain{w_in, INW, 0}, EpiQKVn{PROJ, g_naq, g_nak, g_gq, g_gk}); break;
        case PH_ATT: k_nattn_gqa<<<dim3(SEQ / 64, GQH, NB), 64, 0, stream>>>(PROJ, ATT, SSQP); k_nattn_na<<<dim3(GROWS, NAH, NB), 64, 0, stream>>>(PROJ, rpb, ATT, SSQP); break;
        case PH_OUT: k_mixnorm<<<MTOK / 4, 256, 0, stream>>>(ATT, g_oa, g_ob, MIXED);
                     k_ngemm<1><<<dim3(DM / 64, MTOK / 64), 256, 0, stream>>>((long)MIXW, (const float*)nullptr, RpPlain{MIXED, MIXW, 0}, WpPlain{w_out, DM, 0}, EpiOutn{x, out, H16}); break;
        case PH_ROUTER: k_router<<<MTOK / 128, 512, 0, stream>>>(out, norm2_g, w_router, AFF, RSTD2); break;
        case PH_TOPK: k_topk<<<NB * NEXP, 512, 0, stream>>>(AFF, RSTD2, IDX, RSS, GATE, INV); break;
        case PH_E1: k_ngemm<2><<<dim3(DEXP / 64, NB * NEXP * CAP / 64), 256, 0, stream>>>((long)DM, norm2_g, RpGather{H16, IDX}, WpGU{w_gate, w_up}, EpiActn{ACT, RSS}); break;
        case PH_E2: k_ngemm<1><<<dim3(DM / 64, NB * NEXP * CAP / 64), 256, 0, stream>>>((long)DEXP, (const float*)nullptr, RpPlain{ACT, DEXP, 0}, WpDown{w_down}, EpiYn{Y, GATE}); break;
        case PH_COMB: k_combine<<<MTOK / 4, 256, 0, stream>>>(out, Y, INV); break;
        }
        ++p;
    }
}
```

```cpp
#include <hip/hip_runtime.h>
#include <cstdio>
#include <cstdint>

#define DEVI __device__ __forceinline__
typedef _Float16 f16;
typedef _Float16 f16x2 __attribute__((ext_vector_type(2)));
typedef _Float16 f16x4 __attribute__((ext_vector_type(4)));
typedef _Float16 f16x8 __attribute__((ext_vector_type(8)));
typedef float f32x2 __attribute__((ext_vector_type(2)));
typedef float f32x4 __attribute__((ext_vector_type(4)));
typedef unsigned u32x4 __attribute__((ext_vector_type(4)));
typedef unsigned u32x2 __attribute__((ext_vector_type(2)));
typedef int i32x4 __attribute__((ext_vector_type(4)));
typedef int i32x8 __attribute__((ext_vector_type(8)));

constexpr int NB = 16, SEQ = 2048, DM = 1024, MTOK = NB * SEQ;
constexpr int GRIDW = 64, GROWS = SEQ / GRIDW;
constexpr int HD = 64, NAH = 8, GQH = 8, GKV = 2;
constexpr int INW = 2304, MIXW = 1024;
constexpr int NEXP = 16, CAP = 256, DEXP = 2816;
constexpr int C_NAQ = 0, C_NAK = 512, C_NAV = 1024, C_GQ = 1536, C_GK = 2048, C_GV = 2176;
constexpr float EPS = 1e-6f;
constexpr float LOG2E = 1.4426950408889634f;
constexpr float C2 = 0.125f * LOG2E;

constexpr size_t MiB = 1u << 20;
constexpr size_t WS_CTL = 0;
constexpr size_t WS_SSQP = 2 * MiB;
constexpr size_t WS_AFF = 4 * MiB;
constexpr size_t WS_RSTD2 = 6 * MiB;
constexpr size_t WS_IDX = 7 * MiB;
constexpr size_t WS_RSS = 7 * MiB + 256 * 1024;
constexpr size_t WS_GATE = 7 * MiB + 512 * 1024;
constexpr size_t WS_INV = 8 * MiB;
constexpr size_t WS_WINT = 16 * MiB;
constexpr size_t WS_WOT = 22 * MiB;
constexpr size_t WS_W1T = 24 * MiB;
constexpr size_t WS_W2T = 112 * MiB;
constexpr size_t WS_H8 = 156 * MiB;
constexpr size_t WS_XN = 188 * MiB;
constexpr size_t WS_H16 = 188 * MiB;
constexpr size_t WS_PROJ = 252 * MiB;
constexpr size_t WS_ATT = 396 * MiB;
constexpr size_t WS_ACT = 252 * MiB;
constexpr size_t WS_Y = 460 * MiB;
constexpr size_t WS_PART = 600 * MiB;
constexpr size_t WS_SSQ2P = 640 * MiB;
constexpr size_t WS_RMS1 = 11 * MiB;
constexpr size_t WS_WRT = 10 * MiB;
constexpr size_t WS_PCNT = 16384;
constexpr size_t CTL_ZERO_BYTES = 65536;
constexpr float W_SCALE = 32.f, H_SCALE = 16.f, A_SCALE = 8.f;
constexpr size_t WS_END = 704 * MiB;

struct RopeTab { float c[64][16]; float s[64][16]; };
constexpr double cx_exp(double x) {
    bool neg = x < 0; double y = neg ? -x : x; double term = 1.0, sum = 1.0;
    for (int i = 1; i < 80; ++i) { term *= y / i; sum += term; }
    return neg ? 1.0 / sum : sum;
}
constexpr double cx_sin(double r) { double term = r, sum = r; for (int i = 1; i < 20; ++i) { term *= -r * r / ((2 * i) * (2 * i + 1)); sum += term; } return sum; }
constexpr double cx_cos(double r) { double term = 1.0, sum = 1.0; for (int i = 1; i < 20; ++i) { term *= -r * r / ((2 * i - 1) * (2 * i)); sum += term; } return sum; }
constexpr RopeTab make_rope() {
    RopeTab t{};
    const double LN1E4 = 9.210340371976184, TWO_PI = 6.283185307179586476925;
    for (int j = 0; j < 16; ++j) {
        const double w = cx_exp(-(double)j / 16.0 * LN1E4);
        for (int p = 0; p < 64; ++p) {
            double a = (double)p * w; long k = (long)(a / TWO_PI + 0.5); double r = a - (double)k * TWO_PI;
            t.c[p][j] = (float)cx_cos(r); t.s[p][j] = (float)cx_sin(r);
        }
    }
    return t;
}
__device__ const RopeTab g_rope = make_rope();

#define DPP_ADD(v, ctrl) v += __builtin_bit_cast(float, __builtin_amdgcn_update_dpp(0, __builtin_bit_cast(int, v), ctrl, 0xF, 0xF, true))
DEVI float wave_sum(float v) {
    DPP_ADD(v, 0xB1);
    DPP_ADD(v, 0x4E);
    DPP_ADD(v, 0x141);
    DPP_ADD(v, 0x140);
    { auto r = __builtin_amdgcn_permlane16_swap(__float_as_uint(v), __float_as_uint(v), false, false); v = __uint_as_float(r[0]) + __uint_as_float(r[1]); }
    { auto r = __builtin_amdgcn_permlane32_swap(__float_as_uint(v), __float_as_uint(v), false, false); v = __uint_as_float(r[0]) + __uint_as_float(r[1]); }
    return v;
}
DEVI void h8_to_f(const u32x4 raw, float* f) {
    const f16x8 h = __builtin_bit_cast(f16x8, raw);
#pragma unroll
    for (int i = 0; i < 8; ++i) f[i] = (float)h[i];
}
DEVI float clamp448(float v) { return __builtin_fminf(__builtin_fmaxf(v, -448.f), 448.f); }
DEVI unsigned pk_f8x4(float a, float b, float c, float d) {
    int w = 0; w = __builtin_amdgcn_cvt_pk_fp8_f32(clamp448(a), clamp448(b), w, false); w = __builtin_amdgcn_cvt_pk_fp8_f32(clamp448(c), clamp448(d), w, true); return (unsigned)w; }
DEVI unsigned pk_h2(float a, float b) { f32x2 v = {a, b}; return __builtin_bit_cast(unsigned, __builtin_convertvector(v, f16x2)); }

__global__ __launch_bounds__(256) void k_rmsnorm1(const float* __restrict__ x, const float* __restrict__ g, f16* __restrict__ xn) {
    const int lane = threadIdx.x & 63, wave = threadIdx.x >> 6;
    const int row = blockIdx.x * 4 + wave;
    const f32x4* xr = (const f32x4*)(x + (size_t)row * DM) + lane;
    const f32x4* gr = (const f32x4*)g + lane;
    f32x4 v[4]; float s = 0.f;
#pragma unroll
    for (int j = 0; j < 4; ++j) { v[j] = xr[64 * j]; s += (v[j].x * v[j].x + v[j].y * v[j].y) + (v[j].z * v[j].z + v[j].w * v[j].w); }
    const float rstd = rsqrtf(wave_sum(s) * (1.f / DM) + EPS);
    u32x2* o = (u32x2*)(xn + (size_t)row * DM) + lane;
#pragma unroll
    for (int j = 0; j < 4; ++j) { const f32x4 gg = gr[64 * j]; u32x2 w; w.x = pk_h2(v[j].x * rstd * gg.x, v[j].y * rstd * gg.y); w.y = pk_h2(v[j].z * rstd * gg.z, v[j].w * rstd * gg.w); o[64 * j] = w; }
}

template <int NWM, class RowPtr, class WPtr, class Epi>
__global__ __launch_bounds__(256) void k_ngemm(long Kl, const float* __restrict__ kscale, RowPtr rp, WPtr wp, Epi epi) {
    const int K = (int)Kl;
    __shared__ float As[16][68];
    __shared__ float Ws[NWM][16][64];
    __shared__ float T[NWM][64][65];
    const int tid = threadIdx.x, ty = tid >> 4, tx = tid & 15, rt = blockIdx.y, ct = blockIdx.x;
    float acc[NWM][4][4];
#pragma unroll
    for (int w = 0; w < NWM; ++w)
#pragma unroll
        for (int i = 0; i < 4; ++i)
#pragma unroll
            for (int j = 0; j < 4; ++j) acc[w][i][j] = 0.f;
    const f16* arow = rp(rt, tid >> 2);
    const int ak = (tid & 3) * 4;
    int ldw = 0;
    const float* wb0 = wp(0, rt, ct, ldw);
    const float* wb1 = NWM > 1 ? wp(1, rt, ct, ldw) : wb0;
    for (int k0 = 0; k0 < K; k0 += 16) {
        const u32x2 av = *(const u32x2*)(arow + k0 + ak);
        const f16x4 ah = __builtin_bit_cast(f16x4, av);
#pragma unroll
        for (int i = 0; i < 4; ++i) As[ak + i][tid >> 2] = (float)ah[i] * (kscale ? kscale[k0 + ak + i] : 1.f);
        {
            const f32x4 wv = *(const f32x4*)(wb0 + (size_t)(k0 + (tid >> 4)) * ldw + (tid & 15) * 4);
            *(f32x4*)&Ws[0][tid >> 4][(tid & 15) * 4] = wv;
            if (NWM > 1) { const f32x4 wv1 = *(const f32x4*)(wb1 + (size_t)(k0 + (tid >> 4)) * ldw + (tid & 15) * 4); *(f32x4*)&Ws[NWM - 1][tid >> 4][(tid & 15) * 4] = wv1; }
        }
        __syncthreads();
#pragma unroll
        for (int k = 0; k < 16; ++k) {
            const f32x4 a = *(const f32x4*)&As[k][ty * 4];
#pragma unroll
            for (int w = 0; w < NWM; ++w) {
                const f32x4 b = *(const f32x4*)&Ws[w][k][tx * 4];
#pragma unroll
                for (int i = 0; i < 4; ++i)
#pragma unroll
                    for (int j = 0; j < 4; ++j) acc[w][i][j] += a[i] * b[j];
            }
        }
        __syncthreads();
    }
#pragma unroll
    for (int w = 0; w < NWM; ++w)
#pragma unroll
        for (int i = 0; i < 4; ++i)
#pragma unroll
            for (int j = 0; j < 4; ++j) T[w][ty * 4 + i][tx * 4 + j] = acc[w][i][j];
    __syncthreads();
    epi(T, rt, ct, tid);
}

struct RpPlain { const f16* A; int lda; int pad; DEVI const f16* operator()(int rt, int r) const { return A + (size_t)(rt * 64 + r) * lda; } };
struct WpPlain { const float* W; int ldw_; int pad; DEVI const float* operator()(int, int, int ct, int& ldw) const { ldw = ldw_; return W + ct * 64; } };
struct EpiQKVn {
    f16* proj; const float *g_naq, *g_nak, *g_gq, *g_gk;
    DEVI void operator()(float (*T)[64][65], int rt, int ct, int tid) const {
        const int row = tid >> 2, q4 = tid & 3, grow = rt * 64 + row, hs = ct;
        float v[16];
#pragma unroll
        for (int i = 0; i < 16; ++i) v[i] = T[0][row][q4 * 16 + i];
        const float* g = nullptr; bool rope = false; float sc = 1.f;
        if (hs < 8) { g = g_naq; sc = C2; } else if (hs < 16) { g = g_nak; } else if (hs < 24) { } else if (hs < 32) { g = g_gq; rope = true; sc = C2; } else if (hs < 34) { g = g_gk; rope = true; }
        if (g) {
            float ssq = 0.f;
#pragma unroll
            for (int i = 0; i < 16; ++i) ssq += v[i] * v[i];
            ssq += __shfl_xor(ssq, 1); ssq += __shfl_xor(ssq, 2);
            const float rstd = rsqrtf(ssq * (1.f / 64.f) + EPS);
#pragma unroll
            for (int i = 0; i < 16; ++i) v[i] = v[i] * rstd * g[q4 * 16 + i];
        }
        if (rope) {
            const int t = grow & (SEQ - 1), pos = (q4 < 2) ? (t >> 6) : (t & 63);
#pragma unroll
            for (int i = 0; i < 8; ++i) { const int j = (q4 & 1) * 8 + i; const float c = g_rope.c[pos][j], s = g_rope.s[pos][j]; const float x0 = v[2 * i], x1 = v[2 * i + 1]; v[2 * i] = x0 * c - x1 * s; v[2 * i + 1] = x0 * s + x1 * c; }
        }
        f16* o = proj + (size_t)grow * INW + hs * 64 + q4 * 16;
#pragma unroll
        for (int i = 0; i < 16; ++i) o[i] = (f16)(v[i] * sc);
    }
};

__global__ __launch_bounds__(256) void k_mixnorm(const f16* __restrict__ att, const float* __restrict__ ga, const float* __restrict__ gb, f16* __restrict__ mixed) {
    const int lane = threadIdx.x & 63, wave = threadIdx.x >> 6; const int row = blockIdx.x * 4 + wave;
    const u32x4* a = (const u32x4*)(att + (size_t)row * MIXW + lane * 16);
    float v[16]; h8_to_f(a[0], v); h8_to_f(a[1], v + 8);
    float s = 0.f;
#pragma unroll
    for (int i = 0; i < 16; ++i) s += v[i] * v[i];
#pragma unroll
    for (int o = 1; o < 32; o <<= 1) s += __shfl_xor(s, o);
    const float rstd = rsqrtf(s * (1.f / 512.f) + EPS);
    const float* g = (lane < 32 ? ga : gb) + (lane & 31) * 16;
    u32x4 w0, w1;
    w0.x = pk_h2(v[0] * rstd * g[0], v[1] * rstd * g[1]); w0.y = pk_h2(v[2] * rstd * g[2], v[3] * rstd * g[3]); w0.z = pk_h2(v[4] * rstd * g[4], v[5] * rstd * g[5]); w0.w = pk_h2(v[6] * rstd * g[6], v[7] * rstd * g[7]);
    w1.x = pk_h2(v[8] * rstd * g[8], v[9] * rstd * g[9]); w1.y = pk_h2(v[10] * rstd * g[10], v[11] * rstd * g[11]); w1.z = pk_h2(v[12] * rstd * g[12], v[13] * rstd * g[13]); w1.w = pk_h2(v[14] * rstd * g[14], v[15] * rstd * g[15]);
    u32x4* o = (u32x4*)(mixed + (size_t)row * MIXW + lane * 16); o[0] = w0; o[1] = w1;
}
struct EpiOutn {
    const float* x; float* out; f16* h16;
    DEVI void operator()(float (*T)[64][65], int rt, int ct, int tid) const {
        const int row = tid >> 2, q4 = tid & 3; const size_t off = (size_t)(rt * 64 + row) * DM + ct * 64 + q4 * 16;
#pragma unroll
        for (int i = 0; i < 16; ++i) { const float h = x[off + i] + T[0][row][q4 * 16 + i]; out[off + i] = h; h16[off + i] = (f16)h; }
    }
};

struct RpGather { const f16* H; const int* idx; DEVI const f16* operator()(int rt, int r) const { const int panel = rt >> 2, slot = (rt & 3) * 64 + r, b = panel >> 4; return H + ((size_t)b * SEQ + idx[panel * CAP + slot]) * DM; } };
struct WpGU { const float *Wg, *Wu; DEVI const float* operator()(int w, int rt, int ct, int& ldw) const { const int e = (rt >> 2) & 15; ldw = DEXP; return (w ? Wu : Wg) + (size_t)e * DM * DEXP + ct * 64; } };
struct EpiActn {
    f16* act; const float* rss;
    DEVI void operator()(float (*T)[64][65], int rt, int ct, int tid) const {
        const int row = tid >> 2, q4 = tid & 3; const size_t prow = (size_t)rt * 64 + row; const float rs = rss[prow];
        f16* o = act + prow * DEXP + ct * 64 + q4 * 16;
#pragma unroll
        for (int i = 0; i < 16; ++i) { const float g = T[0][row][q4 * 16 + i] * rs, u = T[1][row][q4 * 16 + i] * rs; o[i] = (f16)(g / (1.f + __expf(-g)) * u); }
    }
};
struct WpDown { const float* Wd; DEVI const float* operator()(int, int rt, int ct, int& ldw) const { const int e = (rt >> 2) & 15; ldw = DM; return Wd + (size_t)e * DEXP * DM + ct * 64; } };
struct EpiYn {
    f16* y; const float* gate;
    DEVI void operator()(float (*T)[64][65], int rt, int ct, int tid) const {
        const int row = tid >> 2, q4 = tid & 3; const size_t prow = (size_t)rt * 64 + row; const float gt = gate[prow];
        f16* o = y + prow * DM + ct * 64 + q4 * 16;
#pragma unroll
        for (int i = 0; i < 16; ++i) o[i] = (f16)(T[0][row][q4 * 16 + i] * gt);
    }
};

__global__ __launch_bounds__(64) void k_nattn_gqa(const f16* __restrict__ proj, f16* __restrict__ att, float* __restrict__ ssqp) {
    __shared__ float Ks[64][64];
    __shared__ float Vs[64][64];
    const int t = threadIdx.x, qi = blockIdx.x * 64 + t, h = blockIdx.y, b = blockIdx.z, kvh = h >> 2;
    const size_t row = (size_t)b * SEQ + qi;
    float q[64], o[64];
    { const u32x4* qp = (const u32x4*)(proj + row * INW + C_GQ + h * 64);
#pragma unroll
      for (int c = 0; c < 8; ++c) h8_to_f(qp[c], q + 8 * c); }
#pragma unroll
    for (int d = 0; d < 64; ++d) o[d] = 0.f;
    float m = -1e30f, l = 0.f;
    for (int kt = 0; kt < SEQ / 64; ++kt) {
        __syncthreads();
#pragma unroll
        for (int c = 0; c < 8; ++c) {
            const int chunk = c * 64 + t, key = chunk >> 3, part = chunk & 7;
            const size_t krow = (size_t)b * SEQ + kt * 64 + key;
            float f[8];
            h8_to_f(*(const u32x4*)(proj + krow * INW + C_GK + kvh * 64 + part * 8), f);
#pragma unroll
            for (int i = 0; i < 8; ++i) Ks[key][part * 8 + i] = f[i];
            h8_to_f(*(const u32x4*)(proj + krow * INW + C_GV + kvh * 64 + part * 8), f);
#pragma unroll
            for (int i = 0; i < 8; ++i) Vs[key][part * 8 + i] = f[i];
        }
        __syncthreads();
        for (int j = 0; j < 64; ++j) {
            float s = 0.f;
#pragma unroll
            for (int d = 0; d < 64; ++d) s += q[d] * Ks[j][d];
            if (s > m) { const float a = exp2f(m - s); l *= a;
#pragma unroll
                for (int d = 0; d < 64; ++d) o[d] *= a;
                m = s; }
            const float p = exp2f(s - m); l += p;
#pragma unroll
            for (int d = 0; d < 64; ++d) o[d] += p * Vs[j][d];
        }
    }
    const float inv = 1.f / l; float ssq = 0.f;
    f16* op = att + row * MIXW + 512 + h * 64;
#pragma unroll
    for (int d = 0; d < 64; ++d) { const f16 hv = (f16)(o[d] * inv); op[d] = hv; const float r = (float)hv; ssq += r * r; }
    ssqp[row * 16 + 8 + h] = ssq;
}
__global__ __launch_bounds__(64) void k_nattn_na(const f16* __restrict__ proj, const float* __restrict__ rpb, f16* __restrict__ att, float* __restrict__ ssqp) {
    const int c = threadIdx.x, r = blockIdx.x, h = blockIdx.y, b = blockIdx.z;
    const size_t row = (size_t)b * SEQ + r * GRIDW + c;
    int rs = r - 4; rs = rs < 0 ? 0 : (rs > GROWS - 8 ? GROWS - 8 : rs);
    int cs = c - 8; cs = cs < 0 ? 0 : (cs > GRIDW - 16 ? GRIDW - 16 : cs);
    float q[64], o[64];
    { const u32x4* qp = (const u32x4*)(proj + row * INW + C_NAQ + h * 64);
#pragma unroll
      for (int cc = 0; cc < 8; ++cc) h8_to_f(qp[cc], q + 8 * cc); }
#pragma unroll
    for (int d = 0; d < 64; ++d) o[d] = 0.f;
    float m = -1e30f, l = 0.f;
    for (int kr = rs; kr < rs + 8; ++kr)
        for (int kc = cs; kc < cs + 16; ++kc) {
            const size_t krow = (size_t)b * SEQ + kr * GRIDW + kc;
            const u32x4* kp = (const u32x4*)(proj + krow * INW + C_NAK + h * 64);
            float s = 0.f;
#pragma unroll
            for (int cc = 0; cc < 8; ++cc) { float f[8]; h8_to_f(kp[cc], f);
#pragma unroll
                for (int i = 0; i < 8; ++i) s += q[8 * cc + i] * f[i]; }
            s += rpb[(h * 15 + (kr - r + 7)) * 31 + (kc - c + 15)] * LOG2E;
            if (s > m) { const float a = exp2f(m - s); l *= a;
#pragma unroll
                for (int d = 0; d < 64; ++d) o[d] *= a;
                m = s; }
            const float p = exp2f(s - m); l += p;
            const u32x4* vp = (const u32x4*)(proj + krow * INW + C_NAV + h * 64);
#pragma unroll
            for (int cc = 0; cc < 8; ++cc) { float f[8]; h8_to_f(vp[cc], f);
#pragma unroll
                for (int i = 0; i < 8; ++i) o[8 * cc + i] += p * f[i]; }
        }
    const float inv = 1.f / l; float ssq = 0.f;
    f16* op = att + row * MIXW + h * 64;
#pragma unroll
    for (int d = 0; d < 64; ++d) { const f16 hv = (f16)(o[d] * inv); op[d] = hv; const float rr = (float)hv; ssq += rr * rr; }
    ssqp[row * 16 + h] = ssq;
}

__global__ __launch_bounds__(512) void k_router(const float* __restrict__ h, const float* __restrict__ g2, const float* __restrict__ wr, float* __restrict__ aff, float* __restrict__ rstd2) {
    __shared__ f32x4 wr4[DM * 4];
    const int tid = threadIdx.x, lane = tid & 63, wave = tid >> 6;
    for (int i = tid; i < DM * 4; i += 512) { const int k = i >> 2, c4 = i & 3; const f32x4 w = ((const f32x4*)wr)[i] * g2[k]; wr4[k * 4 + (c4 ^ ((k >> 2) & 3))] = w; }
    __syncthreads();
    const int sw = (lane >> 2) & 3;
    for (int r = 0; r < 16; ++r) {
        const int t = blockIdx.x * 128 + wave * 16 + r;
        const float* hrow = h + (size_t)t * DM;
        float ssq = 0.f;
        float lg[16];
#pragma unroll
        for (int e = 0; e < 16; ++e) lg[e] = 0.f;
#pragma unroll 2
        for (int i = 0; i < 16; ++i) {
            const int k = lane + 64 * i; const float hv = hrow[k]; ssq += hv * hv;
#pragma unroll
            for (int c4 = 0; c4 < 4; ++c4) { const f32x4 w = wr4[k * 4 + (c4 ^ sw)]; lg[4 * c4 + 0] += hv * w.x; lg[4 * c4 + 1] += hv * w.y; lg[4 * c4 + 2] += hv * w.z; lg[4 * c4 + 3] += hv * w.w; }
        }
        const float rs = rsqrtf(wave_sum(ssq) * (1.f / DM) + EPS);
        float mx = -1e30f;
#pragma unroll
        for (int e = 0; e < 16; ++e) { lg[e] = wave_sum(lg[e]) * rs; mx = fmaxf(mx, lg[e]); }
        float sum = 0.f;
#pragma unroll
        for (int e = 0; e < 16; ++e) { lg[e] = __expf(lg[e] - mx); sum += lg[e]; }
        float mine = 0.f;
#pragma unroll
        for (int e = 0; e < 16; ++e) mine = (lane == e) ? lg[e] : mine;
        const int b = t >> 11, tt = t & (SEQ - 1);
        if (lane < 16) aff[((size_t)b * NEXP + lane) * SEQ + tt] = mine / sum;
        if (lane == 0) rstd2[t] = rs;
    }
}

DEVI int block_sum512(int v, int* red, int tid) {
    const int lane = tid & 63, wave = tid >> 6;
#pragma unroll
    for (int o = 1; o < 64; o <<= 1) v += __shfl_xor(v, o);
    if (lane == 0) red[wave] = v;
    __syncthreads();
    int s = 0;
#pragma unroll
    for (int w = 0; w < 8; ++w) s += red[w];
    return s;
}
DEVI int block_excl_scan512(int v, int* red, int tid) {
    const int lane = tid & 63, wave = tid >> 6;
    int inc = v;
#pragma unroll
    for (int o = 1; o < 64; o <<= 1) { const int n = __shfl_up(inc, o); if (lane >= o) inc += n; }
    if (lane == 63) red[wave] = inc;
    __syncthreads();
    int base = 0;
#pragma unroll
    for (int w = 0; w < 8; ++w) base += (w < wave) ? red[w] : 0;
    return base + inc - v;
}
__global__ __launch_bounds__(512) void k_topk(const float* __restrict__ aff, const float* __restrict__ rstd2, int* __restrict__ idx, float* __restrict__ rss, float* __restrict__ gate, short* __restrict__ inv) {
    __shared__ int red[4][8];
    const int tid = threadIdx.x, be = blockIdx.x, b = be >> 4, e = be & 15;
    const f32x4 a4 = ((const f32x4*)(aff + (size_t)be * SEQ))[tid];
    const float av[4] = {a4.x, a4.y, a4.z, a4.w};
    unsigned bits[4];
#pragma unroll
    for (int j = 0; j < 4; ++j) bits[j] = __float_as_uint(av[j]);
    unsigned lo = 0u, hi = 0x7f800000u;
    int it = 0;
    while (lo < hi) {
        const unsigned mid = lo + ((hi - lo + 1u) >> 1);
        int c = 0;
#pragma unroll
        for (int j = 0; j < 4; ++j) c += (bits[j] >= mid) ? 1 : 0;
        const int tot = block_sum512(c, red[it & 1], tid);
        if (tot >= CAP) lo = mid; else hi = mid - 1u;
        ++it;
    }
    const unsigned theta = lo;
    int cgt = 0, ceq = 0;
#pragma unroll
    for (int j = 0; j < 4; ++j) { cgt += (bits[j] > theta) ? 1 : 0; ceq += (bits[j] == theta) ? 1 : 0; }
    const int ngt = block_sum512(cgt, red[2], tid);
    const int need = CAP - ngt;
    int eqr = block_excl_scan512(ceq, red[3], tid);
    int sel[4]; int csel = 0;
#pragma unroll
    for (int j = 0; j < 4; ++j) { const bool eq = bits[j] == theta; sel[j] = (bits[j] > theta || (eq && eqr < need)) ? 1 : 0; eqr += eq ? 1 : 0; csel += sel[j]; }
    __syncthreads();
    int slot = block_excl_scan512(csel, red[0], tid);
#pragma unroll
    for (int j = 0; j < 4; ++j) {
        const int t = 4 * tid + j;
        short s = -1;
        if (sel[j]) { s = (short)slot; idx[be * CAP + slot] = t; gate[be * CAP + slot] = av[j]; rss[be * CAP + slot] = rstd2[b * SEQ + t]; ++slot; }
        inv[((size_t)b * SEQ + t) * NEXP + e] = s;
    }
}

__global__ __launch_bounds__(256) void k_combine(float* __restrict__ out, const f16* __restrict__ y, const short* __restrict__ inv) {
    const int lane = threadIdx.x & 63, wave = threadIdx.x >> 6; const int row = blockIdx.x * 4 + wave, b = row >> 11;
    f32x4* orow = (f32x4*)(out + (size_t)row * DM) + lane;
    f32x4 v[4];
#pragma unroll
    for (int j = 0; j < 4; ++j) v[j] = orow[64 * j];
    const short* iv = inv + (size_t)row * NEXP;
    for (int e = 0; e < NEXP; ++e) {
        const int s = iv[e];
        if (s >= 0) {
            const u32x2* yr = (const u32x2*)(y + ((size_t)(b * NEXP + e) * CAP + s) * DM) + lane;
#pragma unroll
            for (int j = 0; j < 4; ++j) { const f16x4 hh = __builtin_bit_cast(f16x4, yr[64 * j]); v[j].x += (float)hh[0]; v[j].y += (float)hh[1]; v[j].z += (float)hh[2]; v[j].w += (float)hh[3]; }
        }
    }
#pragma unroll
    for (int j = 0; j < 4; ++j) orow[64 * j] = v[j];
}


#define LAS __attribute__((address_space(3)))
#define GAS __attribute__((address_space(1)))
#define WAIT_V(n) asm volatile("s_waitcnt vmcnt(" #n ")" ::: "memory")
#define WAIT_L(n) asm volatile("s_waitcnt lgkmcnt(" #n ")" ::: "memory")
#define SBAR_RAW __builtin_amdgcn_s_barrier()
#define SCHED0 __builtin_amdgcn_sched_barrier(0)
DEVI int lane_id_v() { int l; asm volatile("v_mbcnt_lo_u32_b32 %0, -1, 0\n\tv_mbcnt_hi_u32_b32 %0, -1, %0" : "=v"(l)); return l; }

namespace pg8 {
constexpr int BM = 256, BK = 64, HALF = 128, HTB = HALF * BK * 2, STAGE_BYTES = 8 * HTB;
__host__ __device__ __forceinline__ int lds_byte(int r, int c) { const int st = (r >> 4) * 2 + (c >> 5), rr = r & 15, cc = c & 31, ob = rr * 64 + cc * 2; return st * 1024 + (ob ^ (((ob >> 9) & 1) << 5)); }
__host__ __device__ __forceinline__ void stage_rc(int b, int& R, int& C) { const int st = b / 1024, sb = b % 1024, swz = sb ^ (((sb >> 9) & 1) << 5); R = (st >> 1) * 16 + swz / 64; C = (st & 1) * 32 + (swz % 64) / 2; }
__host__ __device__ __forceinline__ int sigma_inv(int cl) { return 128 * ((cl >> 5) & 1) + 32 * (cl >> 6) + 16 * ((cl >> 2) & 1) + 4 * ((cl >> 3) & 3) + (cl & 3); }

struct Unit { int pm, pn, aux; };

template <class Epi, class Sched, bool ALIGN_EPI, bool FP8>
DEVI void gemm_phase(LAS unsigned char* lds, const int K, const Sched& S, const Epi& E, const int wid) {
    const int lane = lane_id_v(), tid = wid * 64 + lane, wr = wid >> 2, wc = wid & 3, fr = lane & 15, fq = lane >> 4;
    const int nt = K * (FP8 ? 1 : 2) / 128;
    const int RBA = S.a_pitch(), RBB = S.b_pitch();
    const size_t kstepA = S.a_kstep(), kstepB = S.b_kstep();
    int sR[2], sC[2];
    unsigned voffB[2];
#pragma unroll
    for (int i = 0; i < 2; ++i) { stage_rc(tid * 16 + i * 8192, sR[i], sC[i]); voffB[i] = (unsigned)(sR[i] * RBB + sC[i] * 2); }
    const size_t hstep = (size_t)HALF * RBB;
    const unsigned ldsw = (unsigned)wid * 1024u;
    const int aoff = lds_byte(wr * 64 + fr, fq * 8), boff = lds_byte(wc * 32 + fr, fq * 8);
    LAS unsigned char* const ldsA = lds + aoff; LAS unsigned char* const ldsB = lds + 4 * HTB + boff;
#define PG8_SA(b, h) (((b) * 2 + (h)) * HTB)
#define PG8_SB(b, h) ((4 + (b) * 2 + (h)) * HTB)
#define PG8_STAGE(bufoff, gbase, v0, v1) do { \
        __builtin_amdgcn_global_load_lds((const unsigned*)((const char*)(gbase) + (v0)), (LAS unsigned*)(lds + (bufoff) + ldsw), 16, 0, 0); \
        __builtin_amdgcn_global_load_lds((const unsigned*)((const char*)(gbase) + (v1)), (LAS unsigned*)(lds + (bufoff) + ldsw + 8192), 16, 0, 0); } while (0)
#define PG8_LDF(base_, off_) (*(const LAS f16x8*)((base_) + (off_)))
#define PG8_LDA(dst, b, h) do { _Pragma("unroll") for (int m = 0; m < 4; ++m) { \
        if constexpr (FP8) dst##8[m] = PG8_CAT(PG8_LDF(ldsA, PG8_SA(b, h) + m * 2048), PG8_LDF(ldsA, PG8_SA(b, h) + m * 2048 + 1024)); \
        else { _Pragma("unroll") for (int k = 0; k < 2; ++k) dst[m][k] = PG8_LDF(ldsA, PG8_SA(b, h) + m * 2048 + k * 1024); } } } while (0)
#define PG8_LDB(dst, b, h) do { _Pragma("unroll") for (int n = 0; n < 2; ++n) { \
        if constexpr (FP8) dst##8[n] = PG8_CAT(PG8_LDF(ldsB, PG8_SB(b, h) - 4 * HTB + n * 2048), PG8_LDF(ldsB, PG8_SB(b, h) - 4 * HTB + n * 2048 + 1024)); \
        else { _Pragma("unroll") for (int k = 0; k < 2; ++k) dst[n][k] = PG8_LDF(ldsB, PG8_SB(b, h) - 4 * HTB + n * 2048 + k * 1024); } } } while (0)
#define PG8_CAT(lo_, hi_) __builtin_shufflevector(__builtin_bit_cast(i32x4, lo_), __builtin_bit_cast(i32x4, hi_), 0, 1, 2, 3, 4, 5, 6, 7)
#define PG8_MMA(ai, bj, At, Bt) do { __builtin_amdgcn_s_setprio(1); _Pragma("unroll") for (int m = 0; m < 4; ++m) _Pragma("unroll") for (int n = 0; n < 2; ++n) { \
        if constexpr (FP8) asm volatile("v_mfma_f32_16x16x128_f8f6f4 %0, %1, %2, %0" : "+v"(acc[ai][bj][m][n]) : "v"(Bt##8[n]), "v"(At##8[m]));   \
        else { _Pragma("unroll") for (int k = 0; k < 2; ++k) acc[ai][bj][m][n] = __builtin_amdgcn_mfma_f32_16x16x32_f16(Bt[n][k], At[m][k], acc[ai][bj][m][n], 0, 0, 0); } } \
        __builtin_amdgcn_s_setprio(0); } while (0)
    Unit cur, nxt; int ui = 0;
    if (!S.next(0, cur)) return;
    f32x4 acc[2][2][4][2];
#pragma unroll
    for (int a = 0; a < 2; ++a)
#pragma unroll
        for (int b = 0; b < 2; ++b)
#pragma unroll
            for (int m = 0; m < 4; ++m)
#pragma unroll
                for (int n = 0; n < 2; ++n) acc[a][b][m][n] = (f32x4){0.f, 0.f, 0.f, 0.f};
    f16x8 At[4][2], B0[2][2], B1[2][2];
    const int one_scale = 0x7f7f7f7f;
    i32x8 At8[4], B08[2], B18[2];
    const char* cA = S.a_base(cur); const char* cB = S.b_base(cur);
    unsigned vA00, vA01, vA10, vA11, nA00, nA01, nA10, nA11;
    vA00 = S.a_off(cur, sR[0], sC[0] * 2); vA01 = S.a_off(cur, sR[1], sC[1] * 2);
    vA10 = S.a_off(cur, HALF + sR[0], sC[0] * 2); vA11 = S.a_off(cur, HALF + sR[1], sC[1] * 2);
    nA00 = vA00; nA01 = vA01; nA10 = vA10; nA11 = vA11;
    PG8_STAGE(PG8_SB(0, 0), cB, voffB[0], voffB[1]); PG8_STAGE(PG8_SB(0, 1), cB + hstep, voffB[0], voffB[1]); PG8_STAGE(PG8_SA(0, 0), cA, vA00, vA01); PG8_STAGE(PG8_SA(0, 1), cA, vA10, vA11);
    if (wr == 1) SBAR_RAW;
    WAIT_V(2); SBAR_RAW;
    PG8_STAGE(PG8_SB(1, 0), cB + kstepB, voffB[0], voffB[1]); PG8_STAGE(PG8_SA(1, 0), cA + kstepA, vA00, vA01); PG8_STAGE(PG8_SB(1, 1), cB + hstep + kstepB, voffB[0], voffB[1]);
    WAIT_V(6); SBAR_RAW;
    for (;;) {
        const bool has_next = S.next(ui + 1, nxt);
        const char* nA = has_next ? S.a_base(nxt) : cA; const char* nB = has_next ? S.b_base(nxt) : cB;
#pragma unroll 1
        for (int t = 0; t < nt; t += 2) {
            const bool last = (t == nt - 2);
            if (Epi::HAS_MID) { if (t == (nt >> 1)) E.mid(acc, cur, wr, wc, fr, fq); }
            if (Sched::GATHER) { if (last && has_next) {
                nA00 = S.a_off(nxt, sR[0], sC[0] * 2); nA01 = S.a_off(nxt, sR[1], sC[1] * 2);
                nA10 = S.a_off(nxt, HALF + sR[0], sC[0] * 2); nA11 = S.a_off(nxt, HALF + sR[1], sC[1] * 2); } }
            const char* a1 = cA + (size_t)(t + 1) * kstepA;
            const char* a2 = last ? nA : cA + (size_t)(t + 2) * kstepA; const char* b2 = last ? nB : cB + (size_t)(t + 2) * kstepB;
            const char* a3 = a2 + kstepA; const char* b3 = b2 + kstepB;
            const unsigned w00 = (Sched::GATHER && last) ? nA00 : vA00, w01 = (Sched::GATHER && last) ? nA01 : vA01, w10 = (Sched::GATHER && last) ? nA10 : vA10, w11 = (Sched::GATHER && last) ? nA11 : vA11;
            PG8_LDB(B0, 0, 0); PG8_LDB(B1, 0, 1); SCHED0; PG8_LDA(At, 0, 0); PG8_STAGE(PG8_SA(1, 1), a1, vA10, vA11);
            WAIT_V(8); WAIT_L(0); SBAR_RAW; PG8_MMA(0, 0, At, B0); PG8_MMA(0, 1, At, B1); SBAR_RAW; SCHED0;
            PG8_LDA(At, 0, 1); PG8_STAGE(PG8_SB(0, 0), b2, voffB[0], voffB[1]); PG8_STAGE(PG8_SB(0, 1), b2 + hstep, voffB[0], voffB[1]); PG8_STAGE(PG8_SA(0, 0), a2, w00, w01);
            WAIT_V(8); WAIT_L(0); SBAR_RAW; PG8_MMA(1, 0, At, B0); PG8_MMA(1, 1, At, B1); SBAR_RAW; SCHED0;
            PG8_LDB(B0, 1, 0); PG8_LDB(B1, 1, 1); SCHED0; PG8_LDA(At, 1, 0); PG8_STAGE(PG8_SA(0, 1), a2, w10, w11);
            WAIT_V(8); WAIT_L(0); SBAR_RAW; PG8_MMA(0, 0, At, B0); PG8_MMA(0, 1, At, B1); SBAR_RAW; SCHED0;
            PG8_LDA(At, 1, 1); PG8_STAGE(PG8_SB(1, 0), b3, voffB[0], voffB[1]); PG8_STAGE(PG8_SB(1, 1), b3 + hstep, voffB[0], voffB[1]); PG8_STAGE(PG8_SA(1, 0), a3, w00, w01);
            WAIT_V(8); WAIT_L(0); SBAR_RAW; PG8_MMA(1, 0, At, B0); PG8_MMA(1, 1, At, B1); SBAR_RAW; SCHED0;
        }
        if constexpr (ALIGN_EPI) { if (wr == 0) SBAR_RAW; }
        if constexpr (FP8) asm volatile("s_nop 15\n\ts_nop 7" ::: "memory");
        E(acc, cur, wr, wc, fr, fq);
        if (!has_next) break;
#pragma unroll
        for (int a = 0; a < 2; ++a)
#pragma unroll
            for (int b = 0; b < 2; ++b)
#pragma unroll
                for (int m = 0; m < 4; ++m)
#pragma unroll
                    for (int n = 0; n < 2; ++n) acc[a][b][m][n] = (f32x4){0.f, 0.f, 0.f, 0.f};
        cur = nxt; cA = nA; cB = nB; ++ui;
        if (Sched::GATHER) { vA00 = nA00; vA01 = nA01; vA10 = nA10; vA11 = nA11; }
        if constexpr (ALIGN_EPI) { if (wr == 1) SBAR_RAW; }
    }
    WAIT_V(0);
    if constexpr (!ALIGN_EPI) { if (wr == 0) SBAR_RAW; }
    SBAR_RAW;
#undef PG8_SA
#undef PG8_SB
#undef PG8_STAGE
#undef PG8_LDA
#undef PG8_LDF
#undef PG8_LDB
#undef PG8_MMA
#undef PG8_CAT
}

constexpr int NXCD = 8, WGM = 8;
struct SchedDense {
    static constexpr bool GATHER = false;
    const char* A; const char* Bt; int nM, nN, nwg, G, c; size_t tstep;
    DEVI void init(const void* A_, const void* Bt_, int M, int N, int K, int G_, int c_) { A = (const char*)A_; Bt = (const char*)Bt_; nM = M / BM; nN = N / BM; nwg = nM * nN; G = G_; c = c_; tstep = (size_t)BM * K * 2; }
    DEVI bool next(int i, Unit& u) const {
        const long L = (long)i * G + c; if (L >= nwg) return false;
        int wgid = (int)L; { const int q = nwg / NXCD, r = nwg % NXCD, xcd = wgid % NXCD, off = wgid / NXCD; wgid = (xcd < r ? xcd * (q + 1) : r * (q + 1) + (xcd - r) * q) + off; }
        const int nig = WGM * nN, gid = wgid / nig, fm = gid * WGM, gsz = (nM - fm) < WGM ? (nM - fm) : WGM;
        u.pm = fm + ((wgid % nig) % gsz); u.pn = (wgid % nig) / gsz; u.aux = i; return true;
    }
    DEVI const char* a_base(const Unit& u) const { return A + (size_t)u.pm * tstep; }
    DEVI const char* b_base(const Unit& u) const { return Bt + (size_t)u.pn * tstep; }
    DEVI unsigned a_off(const Unit&, int r, int cb) const { return (unsigned)(r * (int)(tstep / BM) + cb); }
    DEVI int a_pitch() const { return (int)(tstep / BM); } DEVI int b_pitch() const { return (int)(tstep / BM); } DEVI size_t a_kstep() const { return 128; } DEVI size_t b_kstep() const { return 128; }
};
struct SchedE1 {
    static constexpr bool GATHER = true;
    const char* H; const char* W1; const LAS unsigned short* lidx; int G, vcu;
    DEVI int batch_of() const { if (G == 256) { const int x = vcu >> 5, y = vcu & 31; return (x & 3) * 4 + (y & 3); } return vcu & 15; }
    DEVI bool next(int i, Unit& u) const {
        int ep;
        if (G == 256) { if (i >= 22) return false; const int x = vcu >> 5, y = vcu & 31; ep = 16 * i + (x >> 2) * 8 + (y >> 2); }
        else { ep = (vcu >> 4) + i * (G >> 4); if (ep >= 352) return false; }
        const int e = ep / 22; u.pn = ep - e * 22; u.pm = batch_of() * NEXP + e; u.aux = e; return true;
    }
    DEVI const char* a_base(const Unit& u) const { return H + (size_t)(u.pm >> 4) * SEQ * DM; }
    DEVI const char* b_base(const Unit& u) const { return W1 + ((size_t)u.aux * 5632 + (size_t)u.pn * 256) * DM; }
    DEVI unsigned a_off(const Unit& u, int r, int cb) const { return (unsigned)((int)lidx[u.aux * CAP + r] * DM + cb); }
    DEVI int a_pitch() const { return DM; } DEVI int b_pitch() const { return 128; } DEVI size_t a_kstep() const { return 128; } DEVI size_t b_kstep() const { return 32768; }
};
struct SchedE2 {
    static constexpr bool GATHER = false;
    const char* ACT; const char* W2; int G, vcu;
    DEVI bool next(int i, Unit& u) const {
        const long L = (long)i * G + vcu; if (L >= 1024) return false;
        const int e = (int)(L >> 6), q = (int)(L & 63); u.pm = (q >> 2) * NEXP + e; u.pn = q & 3; u.aux = e; return true;
    }
    DEVI const char* a_base(const Unit& u) const { return ACT + (size_t)u.pm * CAP * DEXP; }
    DEVI const char* b_base(const Unit& u) const { return W2 + ((size_t)u.aux * DM + (size_t)u.pn * 256) * DEXP; }
    DEVI unsigned a_off(const Unit&, int r, int cb) const { return (unsigned)((cb >> 5) * 8192 + r * 32 + (cb & 31)); }
    DEVI int a_pitch() const { return 128; } DEVI int b_pitch() const { return 128; } DEVI size_t a_kstep() const { return 32768; } DEVI size_t b_kstep() const { return 32768; }
};

typedef f32x4 AccT[2][2][4][2];
DEVI u32x4 pack8(const f32x4 a, const f32x4 b) { u32x4 w; w.x = pk_h2(a[0], a[1]); w.y = pk_h2(a[2], a[3]); w.z = pk_h2(b[0], b[1]); w.w = pk_h2(b[2], b[3]); return w; }

struct EpiQKV {
    static constexpr bool HAS_MID = false;
    f16* proj; const LAS float* gtab; const LAS float* rtab;
    DEVI void mid(AccT&, const Unit&, int, int, int, int) const {}
    DEVI void operator()(const AccT& acc, const Unit& u, int wr, int wc, int fr, int fq) const {
        const int hs = u.pn * 4 + wc;
        const LAS float* g = nullptr; bool rope = false; float sc = 1.f;
        if (hs < 8) { g = gtab; sc = C2; } else if (hs < 16) { g = gtab + 64; } else if (hs < 24) { } else if (hs < 32) { g = gtab + 128; rope = true; sc = C2; } else if (hs < 34) { g = gtab + 192; rope = true; }
        f32x4 gv[2][2];
#pragma unroll
        for (int bj = 0; bj < 2; ++bj)
#pragma unroll
            for (int n = 0; n < 2; ++n) gv[bj][n] = g ? *(const LAS f32x4*)(g + 32 * bj + 8 * fq + 4 * n) : (f32x4){1.f, 1.f, 1.f, 1.f};
#pragma unroll
        for (int ai = 0; ai < 2; ++ai)
#pragma unroll
            for (int m = 0; m < 4; ++m) {
                const int row = u.pm * BM + ai * HALF + wr * 64 + m * 16 + fr;
                f32x4 v[2][2];
#pragma unroll
                for (int bj = 0; bj < 2; ++bj)
#pragma unroll
                    for (int n = 0; n < 2; ++n) v[bj][n] = acc[ai][bj][m][n];
                if (g) {
                    float ssq = 0.f;
#pragma unroll
                    for (int bj = 0; bj < 2; ++bj)
#pragma unroll
                        for (int n = 0; n < 2; ++n) ssq += (v[bj][n][0] * v[bj][n][0] + v[bj][n][1] * v[bj][n][1]) + (v[bj][n][2] * v[bj][n][2] + v[bj][n][3] * v[bj][n][3]);
                    { auto r_ = __builtin_amdgcn_permlane16_swap(__float_as_uint(ssq), __float_as_uint(ssq), false, false); ssq = __uint_as_float(r_[0]) + __uint_as_float(r_[1]); }
                    { auto r_ = __builtin_amdgcn_permlane32_swap(__float_as_uint(ssq), __float_as_uint(ssq), false, false); ssq = __uint_as_float(r_[0]) + __uint_as_float(r_[1]); }
                    const float rstd = rsqrtf(ssq * (1.f / 64.f) + EPS);
#pragma unroll
                    for (int bj = 0; bj < 2; ++bj)
#pragma unroll
                        for (int n = 0; n < 2; ++n) v[bj][n] = v[bj][n] * rstd * gv[bj][n];
                }
                if (rope) {
                    const int t = row & (SEQ - 1);
#pragma unroll
                    for (int bj = 0; bj < 2; ++bj) {
                        const int pos = bj ? (t & 63) : (t >> 6);
                        const f32x4 cc = *(const LAS f32x4*)(rtab + pos * 16 + 4 * fq), ss = *(const LAS f32x4*)(rtab + 1024 + pos * 16 + 4 * fq);
#pragma unroll
                        for (int n = 0; n < 2; ++n) {
                            const float x0 = v[bj][n][0], x1 = v[bj][n][1], x2 = v[bj][n][2], x3 = v[bj][n][3];
                            v[bj][n][0] = x0 * cc[2 * n] - x1 * ss[2 * n]; v[bj][n][1] = x0 * ss[2 * n] + x1 * cc[2 * n];
                            v[bj][n][2] = x2 * cc[2 * n + 1] - x3 * ss[2 * n + 1]; v[bj][n][3] = x2 * ss[2 * n + 1] + x3 * cc[2 * n + 1];
                        }
                    }
                }
                {
                    const u32x4 d0 = pack8(v[0][0] * sc, v[0][1] * sc), d1 = pack8(v[1][0] * sc, v[1][1] * sc);
                    const bool lowr = fr < 8; u32x4 rcv, s1, s2;
#pragma unroll
                    for (int i = 0; i < 4; ++i) { const unsigned snd = lowr ? d1[i] : d0[i]; rcv[i] = (unsigned)__builtin_amdgcn_update_dpp(0, (int)snd, 0x128, 0xF, 0xF, true); s1[i] = lowr ? d0[i] : rcv[i]; s2[i] = lowr ? rcv[i] : d1[i]; }
                    f16* c0 = proj + (size_t)(row - fr + (fr & 7)) * INW + hs * 64 + 8 * fq + 32 * (fr >> 3);
                    *(u32x4*)c0 = s1; *(u32x4*)(c0 + (size_t)8 * INW) = s2;
                }
            }
    }
};
struct EpiOut {
    static constexpr bool HAS_MID = true;
    const f16* xn; const float* rms1; f16* h16; LAS f32x2* rab; const float* ssq; unsigned char* h8;
    const f16* wrt; float* part; float* ssq2p; unsigned* pcnt; float* aff; float* rstd2; volatile LAS unsigned* flag;
    DEVI void mid(AccT& acc, const Unit& u, int wr, int wc, int fr, int fq) const {
        LAS float* mine = (LAS float*)rab + (wr * 4 + wc) * 128;
        int lofs = (fq * 4) * MTOK + fr; asm volatile("" : "+v"(lofs));
        const float* sp0 = ssq + (size_t)u.pm * BM + wr * 64 + lofs;
#pragma unroll
        for (int g = 0; g < 8; ++g) { const int ai = g >> 2, m = g & 3;
            const float* sp = sp0 + ai * HALF + m * 16;
            float t = (sp[0] + sp[(size_t)MTOK]) + (sp[(size_t)2 * MTOK] + sp[(size_t)3 * MTOK]);
            { auto r_ = __builtin_amdgcn_permlane16_swap(__float_as_uint(t), __float_as_uint(t), false, false); t = __uint_as_float(r_[0]) + __uint_as_float(r_[1]); }
            auto r2 = __builtin_amdgcn_permlane32_swap(__float_as_uint(t), __float_as_uint(t), false, false);
            const float o_ = (fq < 2) ? __uint_as_float(r2[1]) : __uint_as_float(r2[0]);
            const float sa = (fq < 2) ? t : o_, sb = (fq < 2) ? o_ : t;
            const float ra = rsqrtf(sa * (1.f / 512.f) + EPS), rb = rsqrtf(sb * (1.f / 512.f) + EPS), ratio = ra / rb;
            if (fq == 0) mine[g * 16 + fr] = rb;
#pragma unroll
            for (int bj = 0; bj < 2; ++bj)
#pragma unroll
                for (int n = 0; n < 2; ++n) acc[ai][bj][m][n] = acc[ai][bj][m][n] * ratio;
            if (g & 1) SCHED0;
        }
    }
    DEVI void finalize(int pm, int tid) const {
        asm volatile("" : "+v"(tid));
        const int row = pm * BM + (tid >> 1), hf = tid & 1;
        f32x4 l0 = {0.f, 0.f, 0.f, 0.f}, l1 = l0, l2 = l0, l3 = l0; float sq = 0.f;
#pragma unroll
        for (int s8 = 0; s8 < 8; ++s8) { const int sl = hf * 8 + s8; const f32x4* p = (const f32x4*)(part + ((size_t)sl * MTOK + (row & ~15) + ((row & 3) << 2) + ((row >> 2) & 3)) * 16);
            l0 += p[0]; l1 += p[1]; l2 += p[2]; l3 += p[3]; sq += ssq2p[(size_t)sl * MTOK + row]; }
        float lg[16] = {l0[0], l0[1], l0[2], l0[3], l1[0], l1[1], l1[2], l1[3], l2[0], l2[1], l2[2], l2[3], l3[0], l3[1], l3[2], l3[3]};
        float other = __builtin_bit_cast(float, __builtin_amdgcn_update_dpp(0, __builtin_bit_cast(int, sq), 0xB1, 0xF, 0xF, true));
        sq = hf ? (other + sq) : (sq + other);
        const float rs = rsqrtf(sq * (1.f / DM) + EPS);
        float mx = -1e30f;
#pragma unroll
        for (int e = 0; e < 16; ++e) { const float o2 = __builtin_bit_cast(float, __builtin_amdgcn_update_dpp(0, __builtin_bit_cast(int, lg[e]), 0xB1, 0xF, 0xF, true));
            lg[e] = (hf ? (o2 + lg[e]) : (lg[e] + o2)) * rs; mx = fmaxf(mx, lg[e]); }
        float sum = 0.f;
#pragma unroll
        for (int e = 0; e < 16; ++e) { lg[e] = __expf(lg[e] - mx); sum += lg[e]; }
        const float inv = 1.f / sum; const int b = row >> 11, tt = row & (SEQ - 1);
#pragma unroll
        for (int e = 0; e < 16; ++e) if ((e >> 3) == hf) aff[((size_t)b * NEXP + e) * SEQ + tt] = lg[e] * inv;
        if (hf == 0) rstd2[row] = rs;
    }
    struct RowIn { u32x4 a, b; float rm; };
    DEVI void load_rg(RowIn& R, const Unit& u, int g, int wr, int wc, int fr, int fq) const {
        const int row = u.pm * BM + (g >> 2) * HALF + wr * 64 + (g & 3) * 16 + fr;
        const size_t off = (size_t)row * DM + u.pn * BM + wc * 64 + 8 * fq;
        R.a = *(const u32x4*)(xn + off); R.b = *(const u32x4*)(xn + off + 32); R.rm = rms1[row];
    }
    static DEVI void xres(const u32x4 w, float rm, f32x4& x0, f32x4& x1) { const f16x8 h = __builtin_bit_cast(f16x8, w);
        x0 = (f32x4){(float)h[0], (float)h[1], (float)h[2], (float)h[3]} * rm; x1 = (f32x4){(float)h[4], (float)h[5], (float)h[6], (float)h[7]} * rm; }
    DEVI void operator()(const AccT& acc, const Unit& u, int wr, int wc, int fr, int fq) const {
        const int slice = u.pn * 4 + wc;
        const f16* wb = wrt + (size_t)fr * DM + u.pn * BM + wc * 64 + 8 * fq;
        const f16x8 bh0 = *(const f16x8*)(wb), bh1 = *(const f16x8*)(wb + 32), bl0 = *(const f16x8*)(wb + (size_t)NEXP * DM), bl1 = *(const f16x8*)(wb + (size_t)NEXP * DM + 32);
        RowIn Ra, Rb, Rc, Rd;
        load_rg(Ra, u, 0, wr, wc, fr, fq); load_rg(Rb, u, 1, wr, wc, fr, fq); load_rg(Rc, u, 2, wr, wc, fr, fq);
#define EO_GROUP(g, R) do { const int ai = (g) >> 2, m = (g) & 3; \
            const int row16 = u.pm * BM + ai * HALF + wr * 64 + m * 16, row = row16 + fr; \
            const float rb = ((const LAS float*)rab)[(wr * 4 + wc) * 128 + (g) * 16 + fr]; \
            const size_t off = (size_t)row * DM + u.pn * BM + wc * 64 + 8 * fq; \
            f32x4 lg = {0.f, 0.f, 0.f, 0.f}; float sq = 0.f; u32x4 hi8s_[2]; \
            _Pragma("unroll") for (int bj = 0; bj < 2; ++bj) { \
                f32x4 xr0_, xr1_; xres(bj ? R.b : R.a, R.rm, xr0_, xr1_); \
                const f32x4 h0 = xr0_ + acc[ai][bj][m][0] * rb, h1 = xr1_ + acc[ai][bj][m][1] * rb; \
                const u32x4 hi8 = pack8(h0, h1); \
                hi8s_[bj] = hi8; \
                { u32x2 q; q.x = pk_f8x4(h0[0] * H_SCALE, h0[1] * H_SCALE, h0[2] * H_SCALE, h0[3] * H_SCALE); q.y = pk_f8x4(h1[0] * H_SCALE, h1[1] * H_SCALE, h1[2] * H_SCALE, h1[3] * H_SCALE); *(u32x2*)(h8 + off + 32 * bj) = q; } \
                const f16x8 hh = __builtin_bit_cast(f16x8, hi8); \
                const f32x4 d0 = {h0[0] - (float)hh[0], h0[1] - (float)hh[1], h0[2] - (float)hh[2], h0[3] - (float)hh[3]}, d1 = {h1[0] - (float)hh[4], h1[1] - (float)hh[5], h1[2] - (float)hh[6], h1[3] - (float)hh[7]}; \
                const f16x8 hl = __builtin_bit_cast(f16x8, pack8(d0, d1)); \
                lg = __builtin_amdgcn_mfma_f32_16x16x32_f16(hh, bj ? bh1 : bh0, lg, 0, 0, 0); \
                lg = __builtin_amdgcn_mfma_f32_16x16x32_f16(hh, bj ? bl1 : bl0, lg, 0, 0, 0); \
                lg = __builtin_amdgcn_mfma_f32_16x16x32_f16(hl, bj ? bh1 : bh0, lg, 0, 0, 0); \
                sq += ((h0[0] * h0[0] + h0[1] * h0[1]) + (h0[2] * h0[2] + h0[3] * h0[3])) + ((h1[0] * h1[0] + h1[1] * h1[1]) + (h1[2] * h1[2] + h1[3] * h1[3])); } \
            { const bool lowr_ = fr < 8; u32x4 rcv_, s1_, s2_;     \
              _Pragma("unroll") for (int i = 0; i < 4; ++i) { const unsigned snd_ = lowr_ ? hi8s_[1][i] : hi8s_[0][i]; rcv_[i] = (unsigned)__builtin_amdgcn_update_dpp(0, (int)snd_, 0x128, 0xF, 0xF, true); s1_[i] = lowr_ ? hi8s_[0][i] : rcv_[i]; s2_[i] = lowr_ ? rcv_[i] : hi8s_[1][i]; } \
              f16* c0_ = h16 + (size_t)(row16 + (fr & 7)) * DM + u.pn * BM + wc * 64 + 8 * fq + 32 * (fr >> 3); \
              *(u32x4*)c0_ = s1_; *(u32x4*)(c0_ + (size_t)8 * DM) = s2_; } \
            { auto r_ = __builtin_amdgcn_permlane16_swap(__float_as_uint(sq), __float_as_uint(sq), false, false); sq = __uint_as_float(r_[0]) + __uint_as_float(r_[1]); } \
            { auto r_ = __builtin_amdgcn_permlane32_swap(__float_as_uint(sq), __float_as_uint(sq), false, false); sq = __uint_as_float(r_[0]) + __uint_as_float(r_[1]); } \
            if (fq == 0) __hip_atomic_store(ssq2p + (size_t)slice * MTOK + row, sq, __ATOMIC_RELAXED, __HIP_MEMORY_SCOPE_AGENT);     \
            float* pp = part + ((size_t)slice * MTOK + row16 + fq) * 16 + fr;         \
            _Pragma("unroll") for (int r = 0; r < 4; ++r) __hip_atomic_store(pp + r * 64, lg[r], __ATOMIC_RELAXED, __HIP_MEMORY_SCOPE_AGENT); } while (0)
        load_rg(Rd, u, 3, wr, wc, fr, fq); SCHED0; EO_GROUP(0, Ra); SCHED0;
        load_rg(Ra, u, 4, wr, wc, fr, fq); SCHED0; EO_GROUP(1, Rb); SCHED0;
        load_rg(Rb, u, 5, wr, wc, fr, fq); SCHED0; EO_GROUP(2, Rc); SCHED0;
        load_rg(Rc, u, 6, wr, wc, fr, fq); SCHED0; EO_GROUP(3, Rd); SCHED0;
        load_rg(Rd, u, 7, wr, wc, fr, fq); SCHED0; EO_GROUP(4, Ra); SCHED0;
        EO_GROUP(5, Rb); SCHED0;
        EO_GROUP(6, Rc); SCHED0;
        EO_GROUP(7, Rd); SCHED0;
#undef EO_GROUP
        const int lane = fr + 16 * fq; const bool leader = (wr == 0 && wc == 0 && lane == 0);
        asm volatile("s_waitcnt vmcnt(0)" ::: "memory");
        __syncthreads();
        if (leader) {
            const unsigned old = __hip_atomic_fetch_add(pcnt + 64 * u.pm, 1u, __ATOMIC_RELAXED, __HIP_MEMORY_SCOPE_AGENT);
            const unsigned last = (old == 3u) ? 1u : 0u;
            if (last) { __builtin_amdgcn_fence(__ATOMIC_ACQUIRE, "agent"); asm volatile("s_waitcnt vmcnt(0)" ::: "memory"); }
            flag[2] = last;
        }
        __syncthreads();
        if (flag[2]) finalize(u.pm, (wr * 4 + wc) * 64 + lane);
        __syncthreads();
    }
};
struct EpiAct {
    static constexpr bool HAS_MID = false;
    unsigned char* act; const LAS float* lrss;
    DEVI void mid(AccT&, const Unit&, int, int, int, int) const {}
    DEVI void operator()(const AccT& acc, const Unit& u, int wr, int wc, int fr, int fq) const {
#pragma unroll
        for (int ai = 0; ai < 2; ++ai)
#pragma unroll
            for (int m = 0; m < 4; ++m) {
                const size_t prow = (size_t)u.pm * CAP + ai * HALF + wr * 64 + m * 16 + fr;
                const float rs = lrss[u.aux * CAP + ai * HALF + wr * 64 + m * 16 + fr] * (1.f / (H_SCALE * W_SCALE));
                f32x4 a[2];
                const f32x2 rs2 = {rs, rs}, rsn = {rs * -LOG2E, rs * -LOG2E}, rsa = {rs * A_SCALE, rs * A_SCALE}, one2 = {1.f, 1.f};
#pragma unroll
                for (int n = 0; n < 2; ++n)
#pragma unroll
                    for (int i = 0; i < 4; i += 2) {
                        const f32x2 ag = {acc[ai][0][m][n][i], acc[ai][0][m][n][i + 1]}, au = {acc[ai][1][m][n][i], acc[ai][1][m][n][i + 1]};
                        const f32x2 t = ag * rsn; f32x2 d = {__builtin_amdgcn_exp2f(t[0]), __builtin_amdgcn_exp2f(t[1])}; d = d + one2;
                        const f32x2 r = {__builtin_amdgcn_rcpf(d[0]), __builtin_amdgcn_rcpf(d[1])};
                        const f32x2 o = ((ag * rs2) * r) * (au * rsa);
                        a[n][i] = o[0]; a[n][i + 1] = o[1]; }
                u32x2 q; q.x = pk_f8x4(a[0][0], a[0][1], a[0][2], a[0][3]); q.y = pk_f8x4(a[1][0], a[1][1], a[1][2], a[1][3]);
                __builtin_nontemporal_store(q, (u32x2*)(act + ((size_t)u.pm * 22 + u.pn) * 32768 + (size_t)wc * 8192 + (size_t)(ai * HALF + wr * 64 + m * 16 + fr) * 32 + 8 * fq));
            }
    }
};
struct EpiY {
    static constexpr bool HAS_MID = false;
    f16* y; const float* gate;
    DEVI void mid(AccT&, const Unit&, int, int, int, int) const {}
    DEVI void operator()(const AccT& acc, const Unit& u, int wr, int wc, int fr, int fq) const {
        float gts[2][4];
#pragma unroll
        for (int ai = 0; ai < 2; ++ai)
#pragma unroll
            for (int m = 0; m < 4; ++m) gts[ai][m] = gate[(size_t)u.pm * CAP + ai * HALF + wr * 64 + m * 16 + fr];
        asm volatile("s_waitcnt vmcnt(0)" ::: "memory");
        const bool lowr = fr < 8; const int r8 = fr & 7, hb = fr >> 3;
#pragma unroll
        for (int ai = 0; ai < 2; ++ai)
#pragma unroll
            for (int m = 0; m < 4; ++m) {
                const float gt = gts[ai][m] * (1.f / (A_SCALE * W_SCALE));
                const u32x4 d0 = pack8(acc[ai][0][m][0] * gt, acc[ai][0][m][1] * gt), d1 = pack8(acc[ai][1][m][0] * gt, acc[ai][1][m][1] * gt);
                u32x4 rcv;
#pragma unroll
                for (int i = 0; i < 4; ++i) { const unsigned snd = lowr ? d1[i] : d0[i]; rcv[i] = (unsigned)__builtin_amdgcn_update_dpp(0, (int)snd, 0x128, 0xF, 0xF, true); }
                const size_t prow0 = (size_t)u.pm * CAP + ai * HALF + wr * 64 + m * 16;
                f16* c0 = y + u.pn * BM + wc * 64 + 8 * fq + 32 * hb;
                u32x4 s1, s2;
#pragma unroll
                for (int i = 0; i < 4; ++i) { s1[i] = lowr ? d0[i] : rcv[i]; s2[i] = lowr ? rcv[i] : d1[i]; }
                __builtin_nontemporal_store(s1, (u32x4*)(c0 + (prow0 + r8) * DM));
                __builtin_nontemporal_store(s2, (u32x4*)(c0 + (prow0 + 8 + r8) * DM));
            }
    }
};
}

namespace attn_body {
using s16x4 = __attribute__((ext_vector_type(4))) short;
using s16x8 = __attribute__((ext_vector_type(8))) short;
using f32x16 = __attribute__((ext_vector_type(16))) float;
constexpr int NW = 8, QBLK = 32, QB = QBLK * NW, KVBLK = 64, PITCH = INW;
constexpr int NSLOT = 3, SLOTB = 8192;
constexpr int LDS_K = 0, LDS_V = NSLOT * SLOTB, LDS_WS = 2 * NSLOT * SLOTB, LDS_OST = LDS_WS + NW * 64 * 4, LDS_BIAS = LDS_OST + NW * 4096, LDS_BYTES = LDS_BIAS + 640 * 4;
constexpr int BIAS_PAD = 64;
constexpr float NEGBIG = -1000.f;
DEVI int crow(int r, int hi) { return (r & 3) + 8 * (r >> 2) + 4 * hi; }
#define ASBAR() __builtin_amdgcn_sched_barrier(0)
DEVI void glds16s(const void* sbase, unsigned voff, unsigned lds_dst) { unsigned keep;
    asm volatile("s_mov_b32 %0, m0\n\ts_mov_b32 m0, %3\n\ts_nop 0\n\tglobal_load_lds_dwordx4 %1, %2\n\ts_mov_b32 m0, %0" : "=&s"(keep) : "v"(voff), "s"(sbase), "s"(lds_dst) : "memory"); }
DEVI float max3f(float a, float b, float c) { float r; asm("v_max3_f32 %0, %1, %2, %3" : "=v"(r) : "v"(a), "v"(b), "v"(c)); return r; }
DEVI float max2f(float a, float b) { float r; asm("v_max_f32_e32 %0, %1, %2" : "=v"(r) : "v"(a), "v"(b)); return r; }
DEVI float fadd_s(float a, float b) { float r; asm("v_add_f32_e32 %0, %1, %2" : "=v"(r) : "v"(a), "v"(b)); return r; }
DEVI float fsub_s(float a, float b) { float r; asm("v_sub_f32_e32 %0, %1, %2" : "=v"(r) : "v"(a), "v"(b)); return r; }
DEVI unsigned cvtpk_s(float lo, float hi) { return pk_h2(lo, hi); }
#define WAIT_BAR(N) asm volatile("s_waitcnt vmcnt(" #N ") lgkmcnt(0)\n\ts_barrier" ::: "memory")
#define MFMA32(a, b, c) __builtin_amdgcn_mfma_f32_32x32x16_f16(a, b, c, 0, 0, 0)
typedef LAS const char* lds_cptr;
typedef short v4i16_t __attribute__((ext_vector_type(4)));

DEVI void qkt(f32x16& p0, f32x16& p1, const char* Kslot, const f16x8* qr, const f32x16& negm, int r32, int hi) {
    const char* kb = Kslot + hi * 1024 + r32 * 16;
#pragma unroll
    for (int d0 = 0; d0 < 4; ++d0) {
        const f16x8 b0 = *reinterpret_cast<const f16x8*>(kb + d0 * 2048);
        const f16x8 b1 = *reinterpret_cast<const f16x8*>(kb + d0 * 2048 + 512);
        if (d0 == 0) { p0 = MFMA32(b0, qr[0], negm); p1 = MFMA32(b1, qr[0], negm); }
        else { p0 = MFMA32(b0, qr[d0], p0); p1 = MFMA32(b1, qr[d0], p1); } }
}
DEVI void kload8(f16x8* kf, lds_cptr kp) {
    kf[0] = *(const LAS f16x8*)(kp);        kf[1] = *(const LAS f16x8*)(kp + 512);
    kf[2] = *(const LAS f16x8*)(kp + 2048); kf[3] = *(const LAS f16x8*)(kp + 2560);
    kf[4] = *(const LAS f16x8*)(kp + 4096); kf[5] = *(const LAS f16x8*)(kp + 4608);
    kf[6] = *(const LAS f16x8*)(kp + 6144); kf[7] = *(const LAS f16x8*)(kp + 6656);
}
DEVI void kload2(f16x8* kf, lds_cptr kp, int j) { kf[2 * j] = *(const LAS f16x8*)(kp + j * 2048); kf[2 * j + 1] = *(const LAS f16x8*)(kp + j * 2048 + 512); }
DEVI s16x4 vtr(lds_cptr p) { return __builtin_bit_cast(s16x4, __builtin_amdgcn_ds_read_tr16_b64_v4i16((LAS v4i16_t*)p)); }
DEVI float rowmax(const f32x16& p0, const f32x16& p1) {
    float a = max3f(p0[0], p0[1], p1[0]), b = max3f(p0[2], p0[3], p1[1]); a = max3f(a, p1[2], p1[3]);
#pragma unroll
    for (int r = 4; r < 16; r += 4) { a = max3f(a, p0[r], p0[r + 1]); b = max3f(b, p0[r + 2], p0[r + 3]); a = max3f(a, p1[r], p1[r + 1]); b = max3f(b, p1[r + 2], p1[r + 3]); }
    const float m = max2f(a, b);
    auto rr = __builtin_amdgcn_permlane32_swap(__float_as_uint(m), __float_as_uint(m), false, false);
    return max2f(__uint_as_float(rr[0]), __uint_as_float(rr[1]));
}
DEVI void pv(f32x16* o, int vb, f16x8 pa0, f16x8 pa1, f16x8 pa2, f16x8 pa3) {
#pragma unroll
    for (int d0 = 0; d0 < 2; ++d0) { s16x4 lo[4], hi[4];
#pragma unroll
        for (int ks = 0; ks < 4; ++ks) {
            asm volatile("ds_read_b64_tr_b16 %0,%1 offset:%c2" : "=&v"(lo[ks]) : "v"(vb), "i"(d0 * 4096 + ks * 1024) : "memory");
            asm volatile("ds_read_b64_tr_b16 %0,%1 offset:%c2" : "=&v"(hi[ks]) : "v"(vb), "i"(d0 * 4096 + ks * 1024 + 512) : "memory"); }
        asm volatile("s_waitcnt lgkmcnt(0)" ::: "memory"); ASBAR();
#define PK(k) __builtin_bit_cast(f16x8, (s16x8){lo[k][0], lo[k][1], lo[k][2], lo[k][3], hi[k][0], hi[k][1], hi[k][2], hi[k][3]})
        o[d0] = MFMA32(pa0, PK(0), o[d0]);
        o[d0] = MFMA32(pa1, PK(1), o[d0]);
        o[d0] = MFMA32(pa2, PK(2), o[d0]);
        o[d0] = MFMA32(pa3, PK(3), o[d0]);
#undef PK
    }
}

struct AttnU {
    const f16* Qp;
    const f16* Kp;
    const f16* Vp;
    f16* Op;
    float* ssq;
    int NT;
    int r0, kr0;
    const float* rpb_h;
};

template <int THRL, int MODE> DEVI void attn_unit(const AttnU& U, const f16* nQ, const f16* nK, const f16* nV, const bool primed, f16x8 (&qr)[4], char* shm, const int wid) {
    const int lane = lane_id_v(), tid = wid * 64 + lane, r32 = lane & 31, hi = lane >> 5;
    const f16* Qw = U.Qp + (size_t)(wid * QBLK) * PITCH;
    const unsigned lds0 = (unsigned)(uintptr_t)shm;
    float* wsf = (float*)(shm + LDS_WS) + wid * 64;
    const unsigned koff = (unsigned)(lane * PITCH + wid * 8) * 2u;
    const unsigned voff = (unsigned)((16 * (wid & 3) + (lane >> 2)) * PITCH + (wid >> 2) * 32 + (lane & 3) * 8) * 2u;
    const unsigned kdst = lds0 + LDS_K + wid * 1024, vdst = lds0 + LDS_V + wid * 1024;
#define DMA_K(t, slot) glds16s(U.Kp + (size_t)(t) * KVBLK * PITCH, koff, (unsigned)__builtin_amdgcn_readfirstlane(kdst + (slot)))
#define DMA_V(t, slot) glds16s(U.Vp + (size_t)(t) * KVBLK * PITCH, voff, (unsigned)__builtin_amdgcn_readfirstlane(vdst + (slot)))
    const char* Kbase = shm + LDS_K; f16x8 kf[8];
    const lds_cptr shm3 = (lds_cptr)shm; const lds_cptr kp0 = shm3 + LDS_K + hi * 1024 + r32 * 16; const lds_cptr vp0 = shm3 + LDS_V + ((lane >> 4) & 1) * 32 + (lane & 3) * 8 + (4 * hi + ((lane & 15) >> 2)) * 64;
    const int NT = U.NT;
    if (!primed) {
        DMA_K(0, 0); DMA_V(0, 0); DMA_K(1, SLOTB);
#pragma unroll
        for (int d0 = 0; d0 < 4; ++d0) qr[d0] = *reinterpret_cast<const f16x8*>(&Qw[(size_t)r32 * PITCH + d0 * 16 + hi * 8]);
    }
    const LAS float* btab = (const LAS float*)(shm3 + LDS_BIAS);
    int na_lo = 0, na_lb0 = 0, na_rs = 0, na_qr = 0;
    if (MODE == 1) {
        LAS float* bw = (LAS float*)(shm3 + LDS_BIAS);
        if (!primed) for (int i = tid; i < 465; i += 512) bw[BIAS_PAD + i] = U.rpb_h[i] * LOG2E;
        na_qr = U.r0 + (wid >> 1); const int qc = 32 * (wid & 1) + r32;
        int cs = qc - 8; cs = cs < 0 ? 0 : (cs > GRIDW - 16 ? GRIDW - 16 : cs);
        na_rs = na_qr - 4; na_rs = na_rs < 0 ? 0 : (na_rs > GROWS - 8 ? GROWS - 8 : na_rs);
        na_lo = 4 * hi - cs;
        na_lb0 = BIAS_PAD + 15 - qc + 4 * hi;
    }
    float mhat = 0.f, l_reg = 0.f; f32x16 o[2]; o[0] = f32x16{}; o[1] = f32x16{}; f32x16 negm = f32x16{}; if (MODE == 0) asm volatile("" : "+v"(negm));
#define NEGM (MODE == 0 ? negm : f32x16{})
#define HOOK(P0, P1, t) do { if (MODE == 1) { const int kr_ = U.kr0 + (t); const bool rowok_ = (kr_ >= na_rs) && (kr_ < na_rs + 8); \
        if (rowok_) { const LAS float* bp_ = btab + ((kr_ - na_qr + 7) * 31 + na_lb0); const float nm_ = -mhat; \
            _Pragma("unroll") for (int r = 0; r < 16; ++r) { const int c0_ = (r & 3) + 8 * (r >> 2); \
                P0[r] = ((unsigned)(c0_ + na_lo) < 16u) ? (P0[r] + bp_[c0_]) + nm_ : NEGBIG; P1[r] = ((unsigned)(c0_ + 32 + na_lo) < 16u) ? (P1[r] + bp_[c0_ + 32]) + nm_ : NEGBIG; } } \
        else { _Pragma("unroll") for (int r = 0; r < 16; ++r) { P0[r] = NEGBIG; P1[r] = NEGBIG; } } } } while (0)
    bool resc = false;
#define START(P0, P1) do { const float rm = rowmax(P0, P1); resc = false; \
    { const float dl = rm; mhat = fadd_s(mhat, dl); \
      _Pragma("unroll") for (int r = 0; r < 16; ++r) { P0[r] = fsub_s(P0[r], dl); P1[r] = fsub_s(P1[r], dl); } \
      if (MODE == 0) { _Pragma("unroll") for (int r = 0; r < 16; ++r) negm[r] = -mhat; asm volatile("" : "+v"(negm)); } } \
    _Pragma("unroll") for (int r = 0; r < 16; ++r) P0[r] = __builtin_amdgcn_exp2f(P0[r]); } while (0)
#define RESC() do { if (resc) { asm volatile("s_waitcnt lgkmcnt(0)" ::: "memory"); \
      _Pragma("unroll") for (int d_ = 0; d_ < 2; ++d_) _Pragma("unroll") for (int r = 0; r < 16; ++r) o[d_][r] *= wsf[crow(r, hi)]; } } while (0)
    f32x16 pA0, pA1, pB0, pB1;
    int sl_prev = 0, sl_cur = 0, sl_next = SLOTB;
#define ROT() do { sl_prev = sl_cur; sl_cur = sl_next; sl_next = (sl_next == (NSLOT - 1) * SLOTB) ? 0 : sl_next + SLOTB; } while (0)
    DMA_K(2, 2 * SLOTB);
    WAIT_BAR(3);
    qkt(pA0, pA1, Kbase, qr, NEGM, r32, hi); asm volatile("s_nop 15\n\ts_nop 7" : "+v"(pA0), "+v"(pA1)); HOOK(pA0, pA1, 0);
    START(pA0, pA1);
#pragma unroll
    for (int r = 0; r < 16; ++r) pA1[r] = __builtin_amdgcn_exp2f(pA1[r]);
    WAIT_BAR(0);
    DMA_K(3, 0); DMA_V(1, SLOTB);
    ROT();
    kload8(kf, kp0 + sl_cur);
    WAIT_BAR(2);
    s16x4 vlo[8], vhi[8]; u32x4 pw0, pw1, pw2, pw3;
#define PKW(P, B) cvtpk_s(P[B], P[B + 1])
#define PAF(k) __builtin_bit_cast(f16x8, pw##k)
#define VFR(i) __builtin_bit_cast(f16x8, (s16x8){vlo[i][0], vlo[i][1], vlo[i][2], vlo[i][3], vhi[i][0], vhi[i][1], vhi[i][2], vhi[i][3]})
#define PIN(x) asm volatile("" : "+v"(x))
#define MX3(a, b, c) __builtin_fmaxf(__builtin_fmaxf((a), (b)), (c))
#define GAPA(MF, A0, A1, A2, A3, W0, W1, PW) do { MF; sacc += A0; sacc += A1; sacc += A2; sacc += A3; PIN(sacc); W0; W1; PIN(PW); ASBAR(); } while (0)
#define EX(v) __builtin_amdgcn_exp2f(v)
#define GAPB(MF, X, B) do { MF; X[B] = EX(X[B]); X[B + 1] = EX(X[B + 1]); X[B + 2] = EX(X[B + 2]); X[B + 3] = EX(X[B + 3]); PIN(X); ASBAR(); } while (0)
#define VRD(i) do { vlo[i] = vtr(vp_ + (((i) >> 2) * 4096 + ((i) & 3) * 1024)); vhi[i] = vtr(vp_ + (((i) >> 2) * 4096 + ((i) & 3) * 1024 + 512)); } while (0)
#define KRD(G, j) do { if (G) { kload2(kf, kp0 + sl_next, j); ASBAR(); } } while (0)
#define STEP(C0, C1, P0, P1, t, GK, GV, GL) do { ASBAR(); \
    const lds_cptr vp_ = vp0 + sl_prev; \
    VRD(0); ASBAR(); float sacc = (P0[0] + P0[1]); \
    GAPA(C0 = MFMA32(kf[0], qr[0], NEGM), P0[2], P0[3], P0[4], P0[5],     pw0[0] = PKW(P0, 0), pw0[1] = PKW(P0, 2), pw0); \
    VRD(4); ASBAR(); GAPA(C1 = MFMA32(kf[1], qr[0], NEGM), P0[6], P0[7], P0[8], P0[9],     pw0[2] = PKW(P0, 4), pw0[3] = PKW(P0, 6), pw0); \
    VRD(1); ASBAR(); GAPA(C0 = MFMA32(kf[2], qr[1], C0),   P0[10], P0[11], P0[12], P0[13], pw1[0] = PKW(P0, 8), pw1[1] = PKW(P0, 10), pw1); \
    VRD(5); ASBAR(); GAPA(C1 = MFMA32(kf[3], qr[1], C1),   P0[14], P0[15], P1[0], P1[1],   pw1[2] = PKW(P0, 12), pw1[3] = PKW(P0, 14), pw1); \
    VRD(2); ASBAR(); GAPA(C0 = MFMA32(kf[4], qr[2], C0),   P1[2], P1[3], P1[4], P1[5],     pw2[0] = PKW(P1, 0), pw2[1] = PKW(P1, 2), pw2); \
    VRD(6); ASBAR(); GAPA(C1 = MFMA32(kf[5], qr[2], C1),   P1[6], P1[7], P1[8], P1[9],     pw2[2] = PKW(P1, 4), pw2[3] = PKW(P1, 6), pw2); \
    VRD(3); ASBAR(); GAPA(C0 = MFMA32(kf[6], qr[3], C0),   P1[10], P1[11], P1[12], P1[13], pw3[0] = PKW(P1, 8), pw3[1] = PKW(P1, 10), pw3); \
    VRD(7); ASBAR(); GAPA(C1 = MFMA32(kf[7], qr[3], C1),   P1[14], P1[15], 0.f, 0.f,       pw3[2] = PKW(P1, 12), pw3[3] = PKW(P1, 14), pw3); \
    l_reg += sacc; \
    if (GK) { DMA_K((t) + 3, sl_cur); } if (GV) { DMA_V((t) + 1, sl_next); } \
    HOOK(C0, C1, t); \
    { float a = MX3(C0[0], C0[1], C1[0]), b = MX3(C0[2], C0[3], C1[1]); a = MX3(a, C1[2], C1[3]); \
      _Pragma("unroll") for (int r = 4; r < 16; r += 4) { a = MX3(a, C0[r], C0[r + 1]); b = MX3(b, C0[r + 2], C0[r + 3]); a = MX3(a, C1[r], C1[r + 1]); b = MX3(b, C1[r + 2], C1[r + 3]); } \
      float rm = __builtin_fmaxf(a, b); { auto rr = __builtin_amdgcn_permlane32_swap(__float_as_uint(rm), __float_as_uint(rm), false, false); rm = __builtin_fmaxf(__uint_as_float(rr[0]), __uint_as_float(rr[1])); } \
      resc = false; \
      if (__builtin_expect(__any(rm > (float)THRL), 0)) { const float dl = __builtin_fmaxf(rm, 0.f); mhat += dl; \
        _Pragma("unroll") for (int r = 0; r < 16; ++r) { C0[r] -= dl; C1[r] -= dl; } \
        if (MODE == 0) { _Pragma("unroll") for (int r = 0; r < 16; ++r) negm[r] = -mhat; asm volatile("" : "+v"(negm)); } \
        const float f = __builtin_amdgcn_exp2f(-dl); l_reg *= f; if (hi == 0) wsf[r32] = f; resc = true; } } \
    ASBAR(); \
    GAPB(o[0] = MFMA32(PAF(0), VFR(0), o[0]), C0, 0); \
    GAPB(o[1] = MFMA32(PAF(0), VFR(4), o[1]), C0, 4); \
    KRD(GL, 0); GAPB(o[0] = MFMA32(PAF(1), VFR(1), o[0]), C0, 8); \
    KRD(GL, 1); GAPB(o[1] = MFMA32(PAF(1), VFR(5), o[1]), C0, 12); \
    KRD(GL, 2); GAPB(o[0] = MFMA32(PAF(2), VFR(2), o[0]), C1, 0); \
    KRD(GL, 3); GAPB(o[1] = MFMA32(PAF(2), VFR(6), o[1]), C1, 4); \
    GAPB(o[0] = MFMA32(PAF(3), VFR(3), o[0]), C1, 8); \
    GAPB(o[1] = MFMA32(PAF(3), VFR(7), o[1]), C1, 12); \
    } while (0)
    int t = 1;
    for (; t + 5 < NT; t += 2) {
        STEP(pB0, pB1, pA0, pA1, t, true, true, true);       WAIT_BAR(2); RESC(); ROT();
        STEP(pA0, pA1, pB0, pB1, t + 1, true, true, true);   WAIT_BAR(2); RESC(); ROT();
    }
#define ENDW(tt) do { if ((tt) + 3 < NT) { WAIT_BAR(2); } else if ((tt) + 2 < NT) { WAIT_BAR(1); } else { WAIT_BAR(0); } } while (0)
    for (; t + 1 < NT; t += 2) {
        STEP(pB0, pB1, pA0, pA1, t, (t + 3 < NT), (t + 1 < NT), (t + 1 < NT));         ENDW(t);     RESC(); ROT();
        STEP(pA0, pA1, pB0, pB1, t + 1, (t + 4 < NT), (t + 2 < NT), (t + 2 < NT));     ENDW(t + 1); RESC(); ROT();
    }
    STEP(pB0, pB1, pA0, pA1, NT - 1, false, false, false); RESC();
    { float sacc = pB0[0] + pB0[1];
#pragma unroll
      for (int r = 2; r < 16; ++r) sacc += pB0[r];
#pragma unroll
      for (int r = 0; r < 16; ++r) sacc += pB1[r];
      l_reg += sacc;
      pw0 = (u32x4){PKW(pB0, 0), PKW(pB0, 2), PKW(pB0, 4), PKW(pB0, 6)}; pw1 = (u32x4){PKW(pB0, 8), PKW(pB0, 10), PKW(pB0, 12), PKW(pB0, 14)}; pw2 = (u32x4){PKW(pB1, 0), PKW(pB1, 2), PKW(pB1, 4), PKW(pB1, 6)}; pw3 = (u32x4){PKW(pB1, 8), PKW(pB1, 10), PKW(pB1, 12), PKW(pB1, 14)};
      ASBAR(); pv(o, (int)(unsigned)(__SIZE_TYPE__)(vp0 + sl_cur), PAF(0), PAF(1), PAF(2), PAF(3)); }
    if (nK) {
        asm volatile("s_waitcnt lgkmcnt(0)\n\ts_barrier" ::: "memory");
        glds16s(nK, koff, (unsigned)__builtin_amdgcn_readfirstlane(kdst)); glds16s(nV, voff, (unsigned)__builtin_amdgcn_readfirstlane(vdst)); glds16s(nK + (size_t)KVBLK * PITCH, koff, (unsigned)__builtin_amdgcn_readfirstlane(kdst + SLOTB));
        const f16* nQw = nQ + (size_t)(wid * QBLK) * PITCH;
#pragma unroll
        for (int d0 = 0; d0 < 4; ++d0) qr[d0] = *reinterpret_cast<const f16x8*>(&nQw[(size_t)r32 * PITCH + d0 * 16 + hi * 8]);
    }
#undef PKW
#undef PAF
#undef VFR
#undef PIN
#undef MX3
#undef GAPA
#undef GAPB
#undef EX
#undef VRD
#undef KRD
#undef STEP
#undef ENDW
    { auto rr = __builtin_amdgcn_permlane32_swap(__float_as_uint(l_reg), __float_as_uint(l_reg), false, false); l_reg = __uint_as_float(rr[0]) + __uint_as_float(rr[1]); }
    if (hi == 0) wsf[32 + r32] = l_reg; asm volatile("s_waitcnt lgkmcnt(0)" ::: "memory");
    float rli[16];
#pragma unroll
    for (int r = 0; r < 16; ++r) rli[r] = __builtin_amdgcn_rcpf(wsf[32 + crow(r, hi)]);
    f16* Ow = U.Op + (size_t)(wid * QBLK) * MIXW;
    { f16* stg = (f16*)(shm + LDS_OST) + wid * 2048;
#pragma unroll
      for (int r = 0; r < 16; ++r) { const int orow = crow(r, hi);
#pragma unroll
        for (int d0 = 0; d0 < 2; ++d0) stg[orow * 64 + d0 * 32 + r32] = (f16)(o[d0][r] * rli[r]); }
      asm volatile("s_waitcnt lgkmcnt(0)" ::: "memory");
#pragma unroll
      for (int i = 0; i < 4; ++i) { const int row = i * 8 + (lane >> 3), ch = lane & 7; const u32x4 v = *(const u32x4*)(stg + row * 64 + ch * 8); *(u32x4*)(Ow + (size_t)row * MIXW + ch * 8) = v;
        float f[8]; h8_to_f(v, f); float s = 0.f;
#pragma unroll
        for (int j = 0; j < 8; ++j) s += f[j] * f[j];
        s += __shfl_xor(s, 1); s += __shfl_xor(s, 2); s += __shfl_xor(s, 4);
        if (ch == 0) U.ssq[wid * QBLK + row] = s; } }
    if (!nK) asm volatile("s_waitcnt lgkmcnt(0)\n\ts_barrier" ::: "memory");
#undef DMA_K
#undef DMA_V
#undef NEGM
#undef HOOK
#undef START
#undef RESC
#undef ROT
}
#undef ASBAR
#undef WAIT_BAR
#undef MFMA32
}

constexpr int NWAVES = 8, NPHASE = 9;
constexpr int RING_BYTES = 131072, LDS_TOTAL = 163840;
constexpr int LDS_IDX16 = RING_BYTES + 64, LDS_RSS = LDS_IDX16 + 16 * CAP * 2;
enum { PH_PRO = 0, PH_QKV = 1, PH_ATT = 2, PH_OUT = 3, PH_ROUTER = 4, PH_TOPK = 5, PH_E1 = 6, PH_E2 = 7, PH_COMB = 8 };
struct MArgs { const float* in[16]; float* out; unsigned char* ws; int ph_lo, ph_hi; };

template <bool FP8, class RowMap, class KScale>
DEVI void p0_transpose_item(const float* __restrict__ W, int K, int N, void* __restrict__ WTv, LAS float* scr, int item, int lane, const RowMap& rm, const KScale& ks) {
    const int nblk = N / 32, kb = item / nblk, nb = item - kb * nblk, k0 = 64 * kb, n0 = 32 * nb;
#pragma unroll 8
    for (int i = 0; i < 8; ++i) { const int kk = 8 * i + (lane >> 3), nq = 4 * (lane & 7);
        const f32x4 w4 = __builtin_nontemporal_load((const f32x4*)(W + (size_t)(k0 + kk) * N + n0 + nq));
        LAS float* dp = scr + kk * 33 + nq; dp[0] = w4.x; dp[1] = w4.y; dp[2] = w4.z; dp[3] = w4.w; }
    WAIT_L(0); asm volatile("" ::: "memory");
    const int c = lane & 7;
    float kv[8];
#pragma unroll
    for (int q = 0; q < 8; ++q) kv[q] = ks(k0 + 8 * c + q);
#pragma unroll
    for (int j = 0; j < 4; ++j) { const int n = (lane >> 3) + 8 * j; const LAS float* s = scr + (8 * c) * 33 + n;
        if constexpr (FP8) { u32x2 o; o.x = pk_f8x4(s[0 * 33] * kv[0], s[1 * 33] * kv[1], s[2 * 33] * kv[2], s[3 * 33] * kv[3]); o.y = pk_f8x4(s[4 * 33] * kv[4], s[5 * 33] * kv[5], s[6 * 33] * kv[6], s[7 * 33] * kv[7]);
            const int r_ = rm(n0 + n), kk_ = k0 + 8 * c;
            *(u32x2*)((unsigned char*)WTv + ((size_t)(r_ >> 8) * (K >> 7) + (kk_ >> 7)) * 32768 + (size_t)(r_ & 255) * 128 + (kk_ & 127)) = o; }
        else { u32x4 o; o.x = pk_h2(s[0 * 33] * kv[0], s[1 * 33] * kv[1]); o.y = pk_h2(s[2 * 33] * kv[2], s[3 * 33] * kv[3]); o.z = pk_h2(s[4 * 33] * kv[4], s[5 * 33] * kv[5]); o.w = pk_h2(s[6 * 33] * kv[6], s[7 * 33] * kv[7]);
            *(u32x4*)((f16*)WTv + (size_t)rm(n0 + n) * K + k0 + 8 * c) = o; } }
    WAIT_L(0); asm volatile("" ::: "memory");
}
template <class RowMap, class KScale>
DEVI void cv_item128(const float* __restrict__ W, int K, int N, unsigned char* __restrict__ WT, LAS float* scr, int item, int lane, const RowMap& rm, const KScale& ks) {
    const int nblk = N / 32, kb = item / nblk, nb = item - kb * nblk, n0 = 32 * nb;
    const int c = lane & 7;
    u32x2 o[2][4];
#pragma unroll
    for (int h = 0; h < 2; ++h) {
        const int k0 = 128 * kb + 64 * h;
#pragma unroll
        for (int i = 0; i < 8; ++i) { const int kk = 8 * i + (lane >> 3), nq = 4 * (lane & 7);
            const f32x4 w4 = __builtin_nontemporal_load((const f32x4*)(W + (size_t)(k0 + kk) * N + n0 + nq));
            LAS float* dp = scr + kk * 33 + nq; dp[0] = w4.x; dp[1] = w4.y; dp[2] = w4.z; dp[3] = w4.w; }
        WAIT_L(0); asm volatile("" ::: "memory");
        float kv[8]; ks.get8(k0 + 8 * c, kv);
#pragma unroll
        for (int j = 0; j < 4; ++j) { const int n = (lane >> 3) + 8 * j; const LAS float* sp = scr + (8 * c) * 33 + n;
            o[h][j].x = pk_f8x4(sp[0 * 33] * kv[0], sp[1 * 33] * kv[1], sp[2 * 33] * kv[2], sp[3 * 33] * kv[3]); o[h][j].y = pk_f8x4(sp[4 * 33] * kv[4], sp[5 * 33] * kv[5], sp[6 * 33] * kv[6], sp[7 * 33] * kv[7]); }
        WAIT_L(0); asm volatile("" ::: "memory");
    }
    const bool ev = (c & 1) == 0;
#pragma unroll
    for (int j = 0; j < 4; ++j) { const int n = (lane >> 3) + 8 * j, r_ = rm(n0 + n);
        u32x2 rcv;
#pragma unroll
        for (int i = 0; i < 2; ++i) { const unsigned snd = ev ? o[1][j][i] : o[0][j][i]; rcv[i] = (unsigned)__builtin_amdgcn_update_dpp(0, (int)snd, 0xB1, 0xF, 0xF, true); }
        u32x4 d; if (ev) { d.x = o[0][j].x; d.y = o[0][j].y; d.z = rcv.x; d.w = rcv.y; } else { d.x = rcv.x; d.y = rcv.y; d.z = o[1][j].x; d.w = o[1][j].y; }
        *(u32x4*)(WT + ((size_t)(r_ >> 8) * (K >> 7) + kb) * 32768 + (size_t)(r_ & 255) * 128 + (ev ? 8 * c : 64 + 8 * (c - 1))) = d; }
}
struct RmSigma { DEVI int operator()(int n) const { return (n & ~255) + pg8::sigma_inv(n & 255); } };
struct RmGU { int up; DEVI int operator()(int f) const { const int pn = f >> 7, fl = f & 127; return 256 * pn + 128 * up + 32 * (fl >> 5) + 16 * ((fl >> 2) & 1) + 4 * ((fl >> 3) & 3) + (fl & 3); } };
struct KsOne { DEVI float operator()(int) const { return 1.f; } };
struct KsVec { const float* g; float sc; DEVI float operator()(int k) const { return g[k] * sc; }
    DEVI void get8(int k, float (&kv)[8]) const { const f32x4 a = *(const f32x4*)(g + k) * sc, b = *(const f32x4*)(g + k + 4) * sc; kv[0] = a.x; kv[1] = a.y; kv[2] = a.z; kv[3] = a.w; kv[4] = b.x; kv[5] = b.y; kv[6] = b.z; kv[7] = b.w; } };
struct KsConst { float sc; DEVI float operator()(int) const { return sc; }
    DEVI void get8(int, float (&kv)[8]) const { for (int q = 0; q < 8; ++q) kv[q] = sc; } };
struct KsOutG { const float *ga, *gb; DEVI float operator()(int k) const { return k < 512 ? ga[k] : gb[k - 512]; } };

DEVI void rmsnorm1_row(const float* __restrict__ xrow, float* __restrict__ rms_out, f16* __restrict__ orow, int lane) {
    const f32x4* xr = (const f32x4*)xrow + lane;
    f32x4 v[4]; float s = 0.f;
#pragma unroll
    for (int j = 0; j < 4; ++j) { v[j] = __builtin_nontemporal_load(xr + 64 * j); s += (v[j].x * v[j].x + v[j].y * v[j].y) + (v[j].z * v[j].z + v[j].w * v[j].w); }
    const float rstd = rsqrtf(wave_sum(s) * (1.f / DM) + EPS);
    if (lane == 0) *rms_out = 1.f / rstd;
    u32x2* o = (u32x2*)orow + lane;
#pragma unroll
    for (int j = 0; j < 4; ++j) { u32x2 w; w.x = pk_h2(v[j].x * rstd, v[j].y * rstd); w.y = pk_h2(v[j].z * rstd, v[j].w * rstd); o[64 * j] = w; }
}

DEVI void router_phase(LAS unsigned char* lds, const float* __restrict__ h, const float* __restrict__ g2, const float* __restrict__ wr, float* __restrict__ aff, float* __restrict__ rstd2, int bid, int G, const int wave) {
    LAS f32x4* wr4 = (LAS f32x4*)lds;
    const int lane = lane_id_v(), tid = wave * 64 + lane;
    for (int i = tid; i < DM * 4; i += 512) { const int k = i >> 2, c4 = i & 3; const f32x4 w = ((const f32x4*)wr)[i] * g2[k]; wr4[k * 4 + (c4 ^ ((k >> 2) & 3))] = w; }
    __syncthreads();
    const int sw = (lane >> 2) & 3;
#define RT_LOAD(dst, t_) do { const float* hp_ = h + (size_t)(t_) * DM + lane; _Pragma("unroll") for (int i = 0; i < 16; ++i) dst[i] = hp_[64 * i]; } while (0)
#define RT_ROW(src, t_) do { float ssq = 0.f; float lg[16]; \
        _Pragma("unroll") for (int e = 0; e < 16; ++e) lg[e] = 0.f; \
        _Pragma("unroll") for (int i = 0; i < 16; ++i) { const int k = lane + 64 * i; const float hv = src[i]; ssq += hv * hv; \
            _Pragma("unroll") for (int c4 = 0; c4 < 4; ++c4) { const f32x4 w = wr4[k * 4 + (c4 ^ sw)]; lg[4 * c4 + 0] += hv * w.x; lg[4 * c4 + 1] += hv * w.y; lg[4 * c4 + 2] += hv * w.z; lg[4 * c4 + 3] += hv * w.w; } if ((i & 1) == 1) SCHED0; } \
        const float rs = rsqrtf(wave_sum(ssq) * (1.f / DM) + EPS); float mx = -1e30f; \
        _Pragma("unroll") for (int e = 0; e < 16; ++e) { lg[e] = wave_sum(lg[e]) * rs; mx = fmaxf(mx, lg[e]); } \
        float sum = 0.f; \
        _Pragma("unroll") for (int e = 0; e < 16; ++e) { lg[e] = __expf(lg[e] - mx); sum += lg[e]; } \
        float mine = 0.f; \
        _Pragma("unroll") for (int e = 0; e < 16; ++e) mine = (lane == e) ? lg[e] : mine; \
        const int b_ = (t_) >> 11, tt_ = (t_) & (SEQ - 1); \
        if (lane < 16) aff[((size_t)b_ * NEXP + lane) * SEQ + tt_] = mine / sum; \
        if (lane == 0) rstd2[t_] = rs; } while (0)
    for (int item = bid; item < MTOK / 128; item += G) {
        const int t0 = item * 128 + wave * 16;
        float ha[16], hb[16];
        RT_LOAD(ha, t0);
        for (int r = 0; r < 16; r += 2) {
            RT_LOAD(hb, t0 + r + 1);
            RT_ROW(ha, t0 + r);
            if (r + 2 < 16) RT_LOAD(ha, t0 + r + 2);
            RT_ROW(hb, t0 + r + 1);
        }
    }
#undef RT_LOAD
#undef RT_ROW
    __syncthreads();
}
DEVI int lds_block_sum512(int v, LAS int* red, int tid) {
    const int lane = tid & 63, wave = tid >> 6;
#pragma unroll
    for (int o = 1; o < 64; o <<= 1) v += __shfl_xor(v, o);
    if (lane == 0) red[wave] = v;
    __syncthreads();
    int s = 0;
#pragma unroll
    for (int w = 0; w < 8; ++w) s += red[w];
    return s;
}
DEVI int lds_block_excl_scan512(int v, LAS int* red, int tid) {
    const int lane = tid & 63, wave = tid >> 6;
    int inc = v;
#pragma unroll
    for (int o = 1; o < 64; o <<= 1) { const int n = __shfl_up(inc, o); if (lane >= o) inc += n; }
    if (lane == 63) red[wave] = inc;
    __syncthreads();
    int base = 0;
#pragma unroll
    for (int w = 0; w < 8; ++w) base += (w < wave) ? red[w] : 0;
    return base + inc - v;
}
DEVI void topk_phase(LAS unsigned char* lds, const float* __restrict__ aff, const float* __restrict__ rstd2, int* __restrict__ idx, float* __restrict__ rss, float* __restrict__ gate, short* __restrict__ inv, int bid, int G, const int wave) {
    LAS int* red = (LAS int*)lds;
    const int tid = wave * 64 + lane_id_v();
    for (int be = bid; be < NB * NEXP; be += G) {
        const int b = be >> 4, e = be & 15;
        const f32x4 a4 = ((const f32x4*)(aff + (size_t)be * SEQ))[tid];
        const float av[4] = {a4.x, a4.y, a4.z, a4.w};
        unsigned bits[4];
#pragma unroll
        for (int j = 0; j < 4; ++j) bits[j] = __float_as_uint(av[j]);
        unsigned lo = 0u, hi = 0x7f800000u; int it = 0;
        while (lo < hi) {
            const unsigned mid = lo + ((hi - lo + 1u) >> 1);
            int c = 0;
#pragma unroll
            for (int j = 0; j < 4; ++j) c += (bits[j] >= mid) ? 1 : 0;
            const int tot = lds_block_sum512(c, red + 8 * (it & 1), tid);
            if (tot >= CAP) lo = mid; else hi = mid - 1u;
            ++it;
        }
        const unsigned theta = lo;
        int cgt = 0, ceq = 0;
#pragma unroll
        for (int j = 0; j < 4; ++j) { cgt += (bits[j] > theta) ? 1 : 0; ceq += (bits[j] == theta) ? 1 : 0; }
        const int ngt = lds_block_sum512(cgt, red + 16, tid);
        const int need = CAP - ngt;
        int eqr = lds_block_excl_scan512(ceq, red + 24, tid);
        int sel[4]; int csel = 0;
#pragma unroll
        for (int j = 0; j < 4; ++j) { const bool eq = bits[j] == theta; sel[j] = (bits[j] > theta || (eq && eqr < need)) ? 1 : 0; eqr += eq ? 1 : 0; csel += sel[j]; }
        __syncthreads();
        int slot = lds_block_excl_scan512(csel, red, tid);
#pragma unroll
        for (int j = 0; j < 4; ++j) {
            const int t = 4 * tid + j; short s = -1;
            if (sel[j]) { s = (short)slot; idx[be * CAP + slot] = t; gate[be * CAP + slot] = av[j]; rss[be * CAP + slot] = rstd2[b * SEQ + t]; ++slot; }
            inv[(size_t)be * SEQ + t] = s;
        }
        __syncthreads();
    }
}
DEVI int wave_isum(int v) {
#pragma unroll
    for (int o = 1; o < 64; o <<= 1) v += __shfl_xor(v, o);
    return v;
}
DEVI int wave_excl_scan(int v, int lane) {
    int inc = v;
#pragma unroll
    for (int o = 1; o < 64; o <<= 1) { const int n = __shfl_up(inc, o); if (lane >= o) inc += n; }
    return inc - v;
}
DEVI void topk_wave(const float* __restrict__ aff, const float* __restrict__ rstd2, int* __restrict__ idx, float* __restrict__ rss, float* __restrict__ gate, short* __restrict__ inv, int be, int lane) {
    const int b = be >> 4;
    const f32x4* ap = (const f32x4*)(aff + (size_t)be * SEQ + 32 * lane);
    unsigned bits[32];
#pragma unroll
    for (int q = 0; q < 8; ++q) { const f32x4 a = ap[q]; bits[4 * q] = __float_as_uint(a.x); bits[4 * q + 1] = __float_as_uint(a.y); bits[4 * q + 2] = __float_as_uint(a.z); bits[4 * q + 3] = __float_as_uint(a.w); }
    unsigned lo = 0u, hi = 0x7f800000u;
    while (lo < hi) {
        const unsigned mid = lo + ((hi - lo + 1u) >> 1);
        int c = 0;
#pragma unroll
        for (int j = 0; j < 32; ++j) c += (bits[j] >= mid) ? 1 : 0;
        const int tot = __builtin_amdgcn_readfirstlane(wave_isum(c));
        if (tot >= CAP) lo = mid; else hi = mid - 1u;
    }
    const unsigned theta = lo;
    int cgt = 0, ceq = 0;
#pragma unroll
    for (int j = 0; j < 32; ++j) { cgt += (bits[j] > theta) ? 1 : 0; ceq += (bits[j] == theta) ? 1 : 0; }
    const int need = CAP - wave_isum(cgt);
    int eqr = wave_excl_scan(ceq, lane);
    unsigned selm = 0u; int csel = 0;
#pragma unroll
    for (int j = 0; j < 32; ++j) { const bool eq = bits[j] == theta; const bool sl = (bits[j] > theta) || (eq && eqr < need); eqr += eq ? 1 : 0; selm |= sl ? (1u << j) : 0u; csel += sl ? 1 : 0; }
    int slot = wave_excl_scan(csel, lane);
    const f32x4* rp = (const f32x4*)(rstd2 + (size_t)b * SEQ + 32 * lane);
    u32x4* ip = (u32x4*)(inv + (size_t)be * SEQ + 32 * lane);
#pragma unroll
    for (int q = 0; q < 4; ++q) {
        unsigned w[4];
#pragma unroll
        for (int h = 0; h < 2; ++h) { const f32x4 rs = rp[2 * q + h];
#pragma unroll
            for (int i = 0; i < 4; ++i) { const int j = 8 * q + 4 * h + i; unsigned s16 = 0xFFFFu;
                if ((selm >> j) & 1u) { s16 = (unsigned)slot; idx[be * CAP + slot] = 32 * lane + j; gate[be * CAP + slot] = __uint_as_float(bits[j]); rss[be * CAP + slot] = rs[i]; ++slot; }
                if (i & 1) w[2 * h + (i >> 1)] |= s16 << 16; else w[2 * h + (i >> 1)] = s16; } }
        u32x4 o; o.x = w[0]; o.y = w[1]; o.z = w[2]; o.w = w[3]; ip[q] = o;
    }
}
DEVI void combine_acc(f32x4 (&v)[4], const f16* __restrict__ y, const short* __restrict__ invt, int row, int lane) {
    const int b = row >> 11, tt = row & (SEQ - 1);
    int sl[NEXP];
#pragma unroll
    for (int e = 0; e < NEXP; ++e) { const unsigned idx = (unsigned)((b * NEXP + e) * SEQ + tt); const unsigned w = ((const unsigned*)invt)[idx >> 1]; sl[e] = (int)(short)(w >> (16 * (idx & 1))); }
#pragma unroll
    for (int e = 0; e < NEXP; ++e) {
        const int s = sl[e];
        if (s >= 0) {
            const u32x2* yr = (const u32x2*)(y + ((size_t)(b * NEXP + e) * CAP + s) * DM) + lane;
#pragma unroll
            for (int j = 0; j < 4; ++j) { const f16x4 hh = __builtin_bit_cast(f16x4, yr[64 * j]); v[j].x += (float)hh[0]; v[j].y += (float)hh[1]; v[j].z += (float)hh[2]; v[j].w += (float)hh[3]; }
        }
    }
}
DEVI void combine_rows2(float* __restrict__ out, const f16* __restrict__ h16, const f16* __restrict__ y, const short* __restrict__ inv, int row0, int row1, int lane) {
    const u32x2* h0 = (const u32x2*)(h16 + (size_t)row0 * DM) + lane; const u32x2* h1 = (const u32x2*)(h16 + (size_t)row1 * DM) + lane;
    f32x4 v0[4], v1[4];
#pragma unroll
    for (int j = 0; j < 4; ++j) { const f16x4 p = __builtin_bit_cast(f16x4, h0[64 * j]), q = __builtin_bit_cast(f16x4, h1[64 * j]);
        v0[j] = (f32x4){(float)p[0], (float)p[1], (float)p[2], (float)p[3]}; v1[j] = (f32x4){(float)q[0], (float)q[1], (float)q[2], (float)q[3]}; }
    combine_acc(v0, y, inv, row0, lane);
    combine_acc(v1, y, inv, row1, lane);
    f32x4* o0 = (f32x4*)(out + (size_t)row0 * DM) + lane; f32x4* o1 = (f32x4*)(out + (size_t)row1 * DM) + lane;
#pragma unroll
    for (int j = 0; j < 4; ++j) { o0[64 * j] = v0[j]; o1[64 * j] = v1[j]; }
}

#define XB_TMO      128
#define XB_XCNT(j)  (256  + 64 * (j))
#define XB_XSUB(j)  (1280 + 64 * (j))
#define XB_XGEN(j)  (2304 + 64 * (j))
#define XB_TOP      3328
#define XB_TOPGEN   3392
#define XCD_BAR_WORDS 3456
#define XB_SPIN_CAP (1u << 22)
DEVI unsigned xb_ld(unsigned* p)              { return __hip_atomic_load(p, __ATOMIC_RELAXED, __HIP_MEMORY_SCOPE_AGENT); }
DEVI unsigned xb_add(unsigned* p, unsigned v) { return __hip_atomic_fetch_add(p, v, __ATOMIC_RELAXED, __HIP_MEMORY_SCOPE_AGENT); }
DEVI unsigned xb_xcc_id() { return (unsigned)__builtin_amdgcn_s_getreg((3 << 11) | 20) & 0xFu; }
#define XB_SPIN(cond, bar) do { unsigned _sp = 0; while (cond) { __builtin_amdgcn_s_sleep(1); \
    if ((++_sp & 255u) == 0u) { if (xb_ld(&(bar)[XB_TMO])) break; if (_sp > XB_SPIN_CAP) { atomicAdd(&(bar)[XB_TMO], 1u); break; } } } } while (0)
struct XcdBarrier { unsigned* bar; unsigned x; volatile LAS unsigned* st; };
DEVI XcdBarrier xcd_barrier_post(unsigned* bar, volatile LAS unsigned* st, bool leader) {
    XcdBarrier b; b.bar = bar; b.x = xb_xcc_id(); b.st = st;
    if (leader) (void)xb_add(&bar[XB_XCNT(b.x)], 1u);
    return b;
}
DEVI void xcd_barrier_complete(unsigned* bar, unsigned x, unsigned& nloc, unsigned& nx) {
    const unsigned G = gridDim.x;
    unsigned sum, cnt, mine, sp = 0u;
    for (;;) {
        sum = 0u; cnt = 0u; mine = 0u;
#pragma unroll
        for (unsigned j = 0; j < 16; ++j) { const unsigned c = xb_ld(&bar[XB_XCNT(j)]); sum += c; cnt += (c > 0u) ? 1u : 0u; mine = (j == x) ? c : mine; }
        if (sum == G) break;
        __builtin_amdgcn_s_sleep(1);
        if ((++sp & 255u) == 0u) { if (xb_ld(&bar[XB_TMO])) break; if (sp > XB_SPIN_CAP) { atomicAdd(&bar[XB_TMO], 1u); break; } }
    }
    nloc = mine > 0u ? mine : 1u; nx = cnt > 0u ? cnt : 1u;
}
DEVI void xcd_barrier_leader(const XcdBarrier& b) {
    {
        unsigned* bar = b.bar;
        __builtin_amdgcn_s_waitcnt(0);
        unsigned nloc = b.st[0], nx = b.st[1];
        if (nloc == 0u) { xcd_barrier_complete(bar, b.x, nloc, nx); b.st[0] = nloc; b.st[1] = nx; }
        const unsigned old = xb_add(&bar[XB_XSUB(b.x)], 1u);
        const unsigned gen = old / nloc;
        if (old + 1u == (gen + 1u) * nloc) {
            __builtin_amdgcn_fence(__ATOMIC_RELEASE, "agent");
            asm volatile("s_waitcnt vmcnt(0)" ::: "memory");
            const unsigned og = xb_add(&bar[XB_TOP], 1u);
            const unsigned tg = og / nx;
            if (og + 1u == (tg + 1u) * nx) xb_add(&bar[XB_TOPGEN], 1u);
            else XB_SPIN(xb_ld(&bar[XB_TOPGEN]) == tg, bar);
            __builtin_amdgcn_fence(__ATOMIC_ACQUIRE, "agent");
            xb_add(&bar[XB_XGEN(b.x)], 1u);
            asm volatile("s_waitcnt vmcnt(0)" ::: "memory");
        } else {
            XB_SPIN(xb_ld(&bar[XB_XGEN(b.x)]) == gen, bar);
            __builtin_amdgcn_fence(__ATOMIC_ACQUIRE, "agent");
            asm volatile("s_waitcnt vmcnt(0)" ::: "memory");
        }
    }
}
DEVI void xcd_barrier(const XcdBarrier& b, bool leader) {
    asm volatile("s_waitcnt vmcnt(0)" ::: "memory");
    __syncthreads();
    if (leader) xcd_barrier_leader(b);
    __syncthreads();
}

__global__ void __launch_bounds__(NWAVES * 64, 2) mega_fwd(MArgs args) {
    __builtin_assume(__builtin_amdgcn_workitem_id_y() == 0); __builtin_assume(__builtin_amdgcn_workitem_id_z() == 0);
    extern __shared__ __attribute__((aligned(16))) unsigned char lds_raw[];
    LAS unsigned char* lds = (LAS unsigned char*)lds_raw;
    const int wave = __builtin_amdgcn_readfirstlane((int)threadIdx.x >> 6);
    const int G = gridDim.x, bx = blockIdx.x, vcu = (G % 8 == 0) ? (bx % 8) * (G / 8) + bx / 8 : bx;
    const float* x = args.in[0]; const float* norm1_g = args.in[1]; const float* w_in = args.in[2];
    const float* g_naq = args.in[3]; const float* g_nak = args.in[4]; const float* rpb = args.in[5];
    const float* g_gq = args.in[6]; const float* g_gk = args.in[7]; const float* g_oa = args.in[8]; const float* g_ob = args.in[9];
    const float* w_out = args.in[10]; const float* norm2_g = args.in[11]; const float* w_router = args.in[12];
    const float* w_gate = args.in[13]; const float* w_up = args.in[14]; const float* w_down = args.in[15];
    float* out = args.out; unsigned char* ws = args.ws;
    f16* XN = (f16*)(ws + WS_XN); f16* H16 = (f16*)(ws + WS_H16); f16* PROJ = (f16*)(ws + WS_PROJ); f16* ATT = (f16*)(ws + WS_ATT); unsigned char* ACT = ws + WS_ACT; f16* Y = (f16*)(ws + WS_Y); unsigned char* H8 = ws + WS_H8;
    f16* WinT = (f16*)(ws + WS_WINT); f16* WoT = (f16*)(ws + WS_WOT); unsigned char* W1T = ws + WS_W1T; unsigned char* W2T = ws + WS_W2T;
    float* SSQP = (float*)(ws + WS_SSQP); float* AFF = (float*)(ws + WS_AFF); float* RSTD2 = (float*)(ws + WS_RSTD2);
    int* IDX = (int*)(ws + WS_IDX); float* RSS = (float*)(ws + WS_RSS); float* GATE = (float*)(ws + WS_GATE); short* INV = (short*)(ws + WS_INV);
    const int lo = args.ph_lo, hi = args.ph_hi;
#ifndef PH_BUILD
#define PH_BUILD 0x1FF
#endif
#define IN(k) (((PH_BUILD >> (k)) & 1) && lo <= (k) && (k) < hi)
#ifndef REPEAT_PH
#define REPEAT_PH -1
#endif
#ifndef REPEAT_N
#define REPEAT_N 2
#endif
#define REPS(k) for (int rep_ = 0; rep_ < ((REPEAT_PH == (k)) ? REPEAT_N : 1); ++rep_)
#define REPBAR() do { if (rep_ > 0) xcd_barrier(gbar, (wave == 0) && (lane_id_v() == 0)); } while (0)
    volatile LAS unsigned* MISC = (volatile LAS unsigned*)(lds + RING_BYTES);
    const bool leader = (wave == 0) && (lane_id_v() == 0);
    if (leader) { MISC[0] = 0u; MISC[1] = 0u; }
    if (lane_id_v() == 0) MISC[8 + wave] = 0u;
    __syncthreads();
    XcdBarrier gbar; gbar.bar = (unsigned*)(ws + WS_CTL); gbar.x = 0; gbar.st = MISC;
    if (hi - lo > 1 || REPEAT_PH >= 0) gbar = xcd_barrier_post((unsigned*)(ws + WS_CTL), MISC, leader);
#define SEAM(k) do { if (IN(k) && IN((k) + 1)) { xcd_barrier(gbar, (wave == 0) && (lane_id_v() == 0)); } } while (0)
    constexpr int CV_I_GU = (DM / 128) * (DEXP / 32), CV_I_DN = (DEXP / 128) * (DM / 32), CV_N_IT = NEXP * (2 * CV_I_GU + CV_I_DN);
#define CONV_ITEM(it_, scr_, lane_) do { const int e_ = (it_) / (2 * CV_I_GU + CV_I_DN); int r_ = (it_) - e_ * (2 * CV_I_GU + CV_I_DN); \
        if (r_ < CV_I_GU) cv_item128(w_gate + (size_t)e_ * DM * DEXP, DM, DEXP, W1T + (size_t)e_ * 5632 * DM, scr_, r_, lane_, RmGU{0}, KsVec{norm2_g, W_SCALE}); \
        else if (r_ < 2 * CV_I_GU) cv_item128(w_up + (size_t)e_ * DM * DEXP, DM, DEXP, W1T + (size_t)e_ * 5632 * DM, scr_, r_ - CV_I_GU, lane_, RmGU{1}, KsVec{norm2_g, W_SCALE}); \
        else cv_item128(w_down + (size_t)e_ * DEXP * DM, DEXP, DM, W2T + (size_t)e_ * DM * DEXP, scr_, r_ - 2 * CV_I_GU, lane_, RmSigma{}, KsConst{W_SCALE}); } while (0)
    constexpr int CV_POOL = CV_N_IT / 8;
    static_assert(CV_N_IT % 8 == 0, "pools");
    const int cvpool = bx & 7;
    unsigned* cvhead = (unsigned*)(ws + WS_CTL + 57344) + 64 * cvpool;
#define CV_DEQ() ((lane_id_v() == 0) ? __hip_atomic_fetch_add(cvhead, 1u, __ATOMIC_RELAXED, __HIP_MEMORY_SCOPE_AGENT) : 0u)
#define CV_SESSION(STOPPABLE) do { const int lane_ = lane_id_v(); LAS float* scr_ = (LAS float*)(lds + 4096 + wave * 16384); \
        unsigned cur_ = MISC[8 + wave]; \
        if (cur_ == 0u) cur_ = (unsigned)__builtin_amdgcn_readfirstlane(CV_DEQ()) + 1u; \
        for (;;) { \
            if (cur_ - 1u >= (unsigned)CV_POOL) { cur_ = (unsigned)CV_POOL + 1u; break; }        \
            const unsigned pend_ = CV_DEQ(); \
            CONV_ITEM((int)(cur_ - 1u) * 8 + cvpool, scr_, lane_); \
            cur_ = (unsigned)__builtin_amdgcn_readfirstlane(pend_) + 1u; \
            if ((STOPPABLE) && MISC[5] != 0u) break; } \
        MISC[8 + wave] = cur_; } while (0)
#define SEAM_CV(k) do { if (IN(k) && IN((k) + 1)) { \
        asm volatile("s_waitcnt vmcnt(0)" ::: "memory"); \
        if (leader) MISC[5] = 0u; \
        __syncthreads(); \
        if (wave == 0) { if (leader) { xcd_barrier_leader(gbar); MISC[5] = 1u; } } \
        else { if (MISC[8 + wave] != (unsigned)CV_POOL + 1u) CV_SESSION(true); } \
        __syncthreads(); } } while (0)

    if (IN(PH_PRO)) REPS(PH_PRO) {
        REPBAR();
        const int lane = lane_id_v();
        LAS float* scr = (LAS float*)(lds + wave * 16384);
        const int gw = vcu * NWAVES + wave, NGW = G * NWAVES;
        constexpr int I_IN = (DM / 64) * (INW / 32), I_OUT = (DM / 64) * (DM / 32), I_GU = (DM / 64) * (DEXP / 32), I_DN = (DEXP / 64) * (DM / 32);
        for (int it = gw; it < I_IN + I_OUT; it += NGW) {
            int r = it;
            if (r < I_IN) { p0_transpose_item<false>(w_in, DM, INW, WinT, scr, r, lane, RmSigma{}, KsVec{norm1_g, 1.f}); continue; } r -= I_IN;
            p0_transpose_item<false>(w_out, MIXW, DM, WoT, scr, r, lane, RmSigma{}, KsOutG{g_oa, g_ob});
        }
        {
            const int rpw = (MTOK + NGW - 1) / NGW;
#pragma unroll 1
            for (int i = 0; i < rpw; ++i) { const int m = gw * rpw + i; if (m < MTOK) rmsnorm1_row(x + (size_t)m * DM, (float*)(ws + WS_RMS1) + m, XN + (size_t)m * DM, lane); }
        }
        { f16* WRT = (f16*)(ws + WS_WRT);
          for (int i = gw * 64 + lane; i < NEXP * DM; i += NGW * 64) { const int e = i >> 10, k = i & (DM - 1); const float w = w_router[k * NEXP + e] * norm2_g[k]; const f16 hi = (f16)w; WRT[i] = hi; WRT[NEXP * DM + i] = (f16)(w - (float)hi); } }
        __syncthreads();
    }
    SEAM_CV(PH_PRO);
    if (IN(PH_QKV)) REPS(PH_QKV) {
        REPBAR();
        pg8::SchedDense S; S.init(XN, WinT, MTOK, INW, DM, G, bx);
        LAS float* gtabl = (LAS float*)(lds + RING_BYTES + 64); LAS float* ropel = gtabl + 256;
        { const int tid_ = wave * 64 + lane_id_v();
          if (tid_ < 256) { const float* gsrc = tid_ < 64 ? g_naq : tid_ < 128 ? g_nak : tid_ < 192 ? g_gq : g_gk; gtabl[tid_] = gsrc[tid_ & 63]; }
          for (int i = tid_; i < 1024; i += NWAVES * 64) { ropel[i] = g_rope.c[i >> 4][i & 15]; ropel[1024 + i] = g_rope.s[i >> 4][i & 15]; }
          __syncthreads(); }
        pg8::EpiQKV E{PROJ, gtabl, ropel};
        pg8::gemm_phase<pg8::EpiQKV, pg8::SchedDense, true, false>(lds, DM, S, E, wave);
    }
    SEAM_CV(PH_QKV);
    if (IN(PH_ATT)) REPS(PH_ATT) {
        REPBAR();
        for (int u = vcu; u < 256; u += G) {
            const int bkv = u >> 3, b = bkv >> 1, kvh = bkv & 1, qb = u & 7;
            f16x8 qfr[4];
#pragma unroll 1
            for (int i = 0; i < 4; ++i) { const int hq = kvh * 4 + i; const size_t row0 = (size_t)b * SEQ + qb * 256;
                attn_body::AttnU U{PROJ + row0 * INW + C_GQ + hq * 64, PROJ + (size_t)b * SEQ * INW + C_GK + kvh * 64, PROJ + (size_t)b * SEQ * INW + C_GV + kvh * 64,
                                   ATT + row0 * MIXW + 512 + hq * 64, SSQP + (size_t)(8 + hq) * MTOK + row0, 32, 0, 0, nullptr};
                const bool more = i < 3;
                attn_body::attn_unit<8, 0>(U, U.Qp + 64, more ? U.Kp : nullptr, U.Vp, i > 0, qfr, (char*)lds_raw, wave);
            }
        }
        asm volatile("" ::: "memory");
        for (int u = vcu; u < 256; u += G) {
            const int pr = u >> 1, b = pr >> 3, h = pr & 7;
            f16x8 qfrn[4];
#pragma unroll 1
            for (int i = 0; i < 4; ++i) { const int rb = (u & 1) * 4 + i, r0 = rb * 4; int kr0 = r0 - 4; kr0 = kr0 < 0 ? 0 : (kr0 > GROWS - 8 ? GROWS - 8 : kr0);
                const int NT = (rb == 0 || rb == 7) ? 8 : 12; const size_t row0 = (size_t)b * SEQ + r0 * GRIDW, krow0 = (size_t)b * SEQ + kr0 * GRIDW;
                attn_body::AttnU U{PROJ + row0 * INW + C_NAQ + h * 64, PROJ + krow0 * INW + C_NAK + h * 64, PROJ + krow0 * INW + C_NAV + h * 64,
                                   ATT + row0 * MIXW + h * 64, SSQP + (size_t)h * MTOK + row0, NT, r0, kr0, rpb + h * 465};
                const bool more = i < 3;
                int nkr0 = r0 + 4 - 4; nkr0 = nkr0 < 0 ? 0 : (nkr0 > GROWS - 8 ? GROWS - 8 : nkr0); const size_t nrow0 = (size_t)b * SEQ + (r0 + 4) * GRIDW, nkrow0 = (size_t)b * SEQ + nkr0 * GRIDW;
                attn_body::attn_unit<8, 1>(U, PROJ + nrow0 * INW + C_NAQ + h * 64, more ? PROJ + nkrow0 * INW + C_NAK + h * 64 : nullptr, PROJ + nkrow0 * INW + C_NAV + h * 64, i > 0, qfrn, (char*)lds_raw, wave);
            }
        }
    }
    SEAM_CV(PH_ATT);
    if (IN(PH_OUT)) REPS(PH_OUT) {
        REPBAR();
        pg8::SchedDense S; S.init(ATT, WoT, MTOK, DM, MIXW, G, bx);
        LAS f32x2* rab = (LAS f32x2*)(lds + RING_BYTES + 64);
        pg8::EpiOut E{XN, (const float*)(ws + WS_RMS1), H16, rab, SSQP, H8, (const f16*)(ws + WS_WRT), (float*)(ws + WS_PART), (float*)(ws + WS_SSQ2P), (unsigned*)(ws + WS_PCNT), AFF, RSTD2, MISC};
        pg8::gemm_phase<pg8::EpiOut, pg8::SchedDense, true, false>(lds, MIXW, S, E, wave);
    }
    SEAM_CV(PH_OUT);
    if (IN(PH_TOPK)) REPS(PH_TOPK) { REPBAR();
        {
            const int lane = lane_id_v();
            if (wave == 0) for (int be = bx; be < NB * NEXP; be += G) topk_wave(AFF, RSTD2, IDX, RSS, GATE, INV, be, lane);
            LAS float* scr = (LAS float*)(lds + 4096 + wave * 16384);
            const int NGW = G * NWAVES;
            CV_SESSION(false);
            __syncthreads();
        } }
    SEAM(PH_TOPK);
    if (IN(PH_E1)) REPS(PH_E1) {
        REPBAR();
        pg8::SchedE1 S{(const char*)H8, (const char*)W1T, (const LAS unsigned short*)(lds + LDS_IDX16), G, vcu};
        {
            const int b_ = S.batch_of(), tid_ = wave * 64 + lane_id_v();
            LAS unsigned short* wi = (LAS unsigned short*)(lds + LDS_IDX16); LAS float* wr_ = (LAS float*)(lds + LDS_RSS);
            for (int i = tid_; i < NEXP * CAP; i += NWAVES * 64) { wi[i] = (unsigned short)IDX[b_ * NEXP * CAP + i]; wr_[i] = RSS[b_ * NEXP * CAP + i]; }
            __syncthreads();
        }
        pg8::EpiAct E{ACT, (const LAS float*)(lds + LDS_RSS)};
        pg8::gemm_phase<pg8::EpiAct, pg8::SchedE1, true, true>(lds, DM, S, E, wave);
    }
    SEAM(PH_E1);
    if (IN(PH_E2)) REPS(PH_E2) {
        REPBAR();
        pg8::SchedE2 S{(const char*)ACT, (const char*)W2T, G, vcu};
        pg8::EpiY E{Y, GATE};
        pg8::gemm_phase<pg8::EpiY, pg8::SchedE2, true, true>(lds, DEXP, S, E, wave);
    }
    SEAM(PH_E2);
    if (IN(PH_COMB)) REPS(PH_COMB) {
        REPBAR();
        const int lane = lane_id_v();
        const int gw = vcu * NWAVES + wave, NGW = G * NWAVES;
        for (int m = gw; m < MTOK; m += 2 * NGW) combine_rows2(out, H16, Y, INV, m, m + NGW, lane);
    }
#undef IN
#undef SEAM
}

#ifndef MEGA_MASK
#define MEGA_MASK 0x1FF
#endif
#ifndef ONE_LAUNCH
#define ONE_LAUNCH 1
#endif
static_assert(MEGA_MASK == 0x1FF && ONE_LAUNCH == 1, "the fp8 expert path needs the persistent-kernel forms of P0, P3, E1 and E2 (the simple kernels use the older f16 buffers)");
extern "C" void kernel_launch(void* const* d_in, const int* in_sizes, int n_in, void* d_out, int out_size, void* d_ws, size_t ws_size, hipStream_t stream) {
    static int grid = 0;
    if (grid == 0) {
        if (n_in != 16 || out_size != MTOK * DM || ws_size < WS_END) { fprintf(stderr, "kernel_launch: unexpected shapes (n_in %d out %d ws %zu, need %zu)\n", n_in, out_size, ws_size, (size_t)WS_END); grid = -1; return; }
        int dev = 0, cus = 0, per_cu = 0;
        if (hipGetDevice(&dev) != hipSuccess || hipDeviceGetAttribute(&cus, hipDeviceAttributeMultiprocessorCount, dev) != hipSuccess) { grid = -1; return; }
        if (hipFuncSetAttribute((const void*)mega_fwd, hipFuncAttributeMaxDynamicSharedMemorySize, LDS_TOTAL) != hipSuccess) { fprintf(stderr, "kernel_launch: hipFuncSetAttribute failed\n"); grid = -1; return; }
        if (hipOccupancyMaxActiveBlocksPerMultiprocessor(&per_cu, (const void*)mega_fwd, NWAVES * 64, LDS_TOTAL) != hipSuccess || per_cu < 1) { fprintf(stderr, "kernel_launch: occupancy query says %d\n", per_cu); per_cu = 1; }
        (void)hipGetLastError();
        grid = cus * 1;
        if (grid % 16 != 0 || grid < 64) { fprintf(stderr, "kernel_launch: %d CUs: the expert phase needs a grid that is a multiple of 16\n", cus); grid = -1; return; }
    }
    if (grid < 0) return;
    const float* x = (const float*)d_in[0]; const float* norm1_g = (const float*)d_in[1]; const float* w_in = (const float*)d_in[2];
    const float* g_naq = (const float*)d_in[3]; const float* g_nak = (const float*)d_in[4]; const float* rpb = (const float*)d_in[5];
    const float* g_gq = (const float*)d_in[6]; const float* g_gk = (const float*)d_in[7]; const float* g_oa = (const float*)d_in[8]; const float* g_ob = (const float*)d_in[9];
    const float* w_out = (const float*)d_in[10]; const float* norm2_g = (const float*)d_in[11]; const float* w_router = (const float*)d_in[12];
    const float* w_gate = (const float*)d_in[13]; const float* w_up = (const float*)d_in[14]; const float* w_down = (const float*)d_in[15];
    float* out = (float*)d_out; char* ws = (char*)d_ws;
    f16* XN = (f16*)(ws + WS_XN); f16* H16 = (f16*)(ws + WS_H16); f16* PROJ = (f16*)(ws + WS_PROJ); f16* ATT = (f16*)(ws + WS_ATT); f16* ACT = (f16*)(ws + WS_ACT); f16* Y = (f16*)(ws + WS_Y);
    float* SSQP = (float*)(ws + WS_SSQP); float* AFF = (float*)(ws + WS_AFF); float* RSTD2 = (float*)(ws + WS_RSTD2);
    int* IDX = (int*)(ws + WS_IDX); float* RSS = (float*)(ws + WS_RSS); float* GATE = (float*)(ws + WS_GATE); short* INV = (short*)(ws + WS_INV);
    f16* MIXED = (f16*)(ws + 560 * MiB);
    MArgs a{};
    for (int i = 0; i < 16; ++i) a.in[i] = (const float*)d_in[i];
    a.out = out; a.ws = (unsigned char*)d_ws;
    int p = 0;
    while (p < NPHASE) {
        if ((MEGA_MASK >> p) & 1) {
            int q = p + 1;
            if (ONE_LAUNCH) while (q < NPHASE && ((MEGA_MASK >> q) & 1)) ++q;
            a.ph_lo = p; a.ph_hi = q;
            if (q - p > 1 || REPEAT_PH >= 0) (void)hipMemsetAsync((char*)d_ws + WS_CTL, 0, CTL_ZERO_BYTES, stream);
            void* kargs[] = {&a};
            hipError_t e = hipLaunchCooperativeKernel((const void*)mega_fwd, dim3(grid), dim3(NWAVES * 64), kargs, LDS_TOTAL, stream);
            if (e != hipSuccess) fprintf(stderr, "kernel_launch: cooperative launch failed: %s (grid %d)\n", hipGetErrorString(e), grid);
            p = q; continue;
        }
        switch (p) {
        case PH_PRO: k_rmsnorm1<<<MTOK / 4, 256, 0, stream>>>(x, norm1_g, XN); break;
        case PH_QKV: k_ngemm<1><<<dim3(INW / 64, MTOK / 64), 256, 0, stream>>>((long)DM, (const float*)nullptr, RpPlain{XN, DM, 0}, WpPlain{w_in, INW, 0}, EpiQKVn{PROJ, g_naq, g_nak, g_gq, g_gk}); break;
        case PH_ATT: k_nattn_gqa<<<dim3(SEQ / 64, GQH, NB), 64, 0, stream>>>(PROJ, ATT, SSQP); k_nattn_na<<<dim3(GROWS, NAH, NB), 64, 0, stream>>>(PROJ, rpb, ATT, SSQP); break;
        case PH_OUT: k_mixnorm<<<MTOK / 4, 256, 0, stream>>>(ATT, g_oa, g_ob, MIXED);
                     k_ngemm<1><<<dim3(DM / 64, MTOK / 64), 256, 0, stream>>>((long)MIXW, (const float*)nullptr, RpPlain{MIXED, MIXW, 0}, WpPlain{w_out, DM, 0}, EpiOutn{x, out, H16}); break;
        case PH_ROUTER: k_router<<<MTOK / 128, 512, 0, stream>>>(out, norm2_g, w_router, AFF, RSTD2); break;
        case PH_TOPK: k_topk<<<NB * NEXP, 512, 0, stream>>>(AFF, RSTD2, IDX, RSS, GATE, INV); break;
        case PH_E1: k_ngemm<2><<<dim3(DEXP / 64, NB * NEXP * CAP / 64), 256, 0, stream>>>((long)DM, norm2_g, RpGather{H16, IDX}, WpGU{w_gate, w_up}, EpiActn{ACT, RSS}); break;
        case PH_E2: k_ngemm<1><<<dim3(DM / 64, NB * NEXP * CAP / 64), 256, 0, stream>>>((long)DEXP, (const float*)nullptr, RpPlain{ACT, DEXP, 0}, WpDown{w_down}, EpiYn{Y, GATE}); break;
        case PH_COMB: k_combine<<<MTOK / 4, 256, 0, stream>>>(out, Y, INV); break;
        }
        ++p;
    }
}
```
